# Optimizing an MI355X kernel written in HIP

```python
import jax, jax.numpy as jnp
from jax import lax
import numpy as np

D_MODEL = 1024
BATCH = 32
SEQ = 2048
DEPTH = 2

CTX_LEN = 256
GRID_W = 64
CHUNK = 128
GM_GROUPS = 8
GM_WIDTH = 1024
GM_GROUP_DIM = GM_WIDTH // GM_GROUPS
N_HEADS = 8
Q_LORA = 384
KV_LORA = 256
QK_NOPE = 128
QK_ROPE = 64
V_HEAD = 128
ROPE_THETA = 10000.0
Q_BLOCK = 128
N_EXPERTS = 16
N_EXPERT_GROUPS = 4
EXPERTS_PER_GROUP = N_EXPERTS // N_EXPERT_GROUPS
TOP_K = 2
D_EXPERT = 512
MOE_BLOCK = 512
LN_EPS = 1e-5
ALPHA = (2.0 * DEPTH) ** 0.25
BETA = (8.0 * DEPTH) ** -0.25

OFF_Q = 2 * GM_WIDTH
OFF_KV = OFF_Q + Q_LORA
OFF_KR = OFF_KV + KV_LORA
OFF_G = OFF_KR + QK_ROPE
IN_COLS = OFF_G + 2 * D_MODEL

kernel_name = "hybrid_gmlp_mla_moe_diffusion_block"


def layer_norm(x, g, b):
    x32 = x.astype(jnp.float32)
    mu = x32.mean(-1, keepdims=True)
    var = jnp.square(x32 - mu).mean(-1, keepdims=True)
    return ((x32 - mu) * lax.rsqrt(var + LN_EPS) * g + b).astype(x.dtype)


def rms_norm(x, g):
    x32 = x.astype(jnp.float32)
    return (x32 * lax.rsqrt(jnp.square(x32).mean(-1, keepdims=True) + LN_EPS) * g).astype(x.dtype)


def axial_rope(length, dtype):
    rows = length // GRID_W
    row = jnp.repeat(jnp.arange(rows), GRID_W).astype(jnp.float32)
    col = jnp.tile(jnp.arange(GRID_W), rows).astype(jnp.float32)
    n_freq = QK_ROPE // 4
    inv = ROPE_THETA ** (-jnp.arange(n_freq, dtype=jnp.float32) / n_freq)
    ang = jnp.concatenate([row[:, None] * inv, col[:, None] * inv], axis=-1)
    return jnp.cos(ang).astype(dtype), jnp.sin(ang).astype(dtype)


def apply_rope(x, cos, sin):
    half = x.shape[-1] // 2
    x1, x2 = x[..., :half], x[..., half:]
    return jnp.concatenate([x1 * cos - x2 * sin, x1 * sin + x2 * cos], axis=-1)


def mla_q(q_a, q_norm, w_uq, rope):
    q = (rms_norm(q_a, q_norm) @ w_uq).reshape(*q_a.shape[:2], N_HEADS, QK_NOPE + QK_ROPE)
    q_nope, q_rope = q[..., :QK_NOPE], q[..., QK_NOPE:]
    if rope is not None:
        q_rope = apply_rope(q_rope, rope[0][:, None, :], rope[1][:, None, :])
    return q_nope, q_rope


def mla_kv(p_kv, kv_norm, w_ukv, rope):
    kv_a, k_rope = p_kv[..., :KV_LORA], p_kv[..., KV_LORA:]
    kv = (rms_norm(kv_a, kv_norm) @ w_ukv).reshape(*p_kv.shape[:2], N_HEADS, QK_NOPE + V_HEAD)
    if rope is not None:
        k_rope = apply_rope(k_rope, rope[0], rope[1])
    return kv[..., :QK_NOPE], k_rope, kv[..., QK_NOPE:]


def attend(q_nope, q_rope, k_nope, k_rope, v):
    scale = (QK_NOPE + QK_ROPE) ** -0.5
    s = jnp.einsum('bqhd,bkhd->bhqk', q_nope, k_nope) + jnp.einsum('bqhr,bkr->bhqk', q_rope, k_rope)
    p = jax.nn.softmax(s.astype(jnp.float32) * scale, axis=-1).astype(v.dtype)
    return jnp.einsum('bhqk,bkhd->bqhd', p, v)


def blocked_attend(q_nope, q_rope, k_nope, k_rope, v):
    b, lq = q_nope.shape[:2]
    nblk = lq // Q_BLOCK

    def to_blocks(t):
        return jnp.moveaxis(t.reshape(b, nblk, Q_BLOCK, *t.shape[2:]), 1, 0)

    out = lax.map(lambda qs: attend(qs[0], qs[1], k_nope, k_rope, v), (to_blocks(q_nope), to_blocks(q_rope)))
    return jnp.moveaxis(out, 0, 1).reshape(b, lq, N_HEADS, V_HEAD)


def chunk_gmlp(u, v, ln_g, ln_b, w_s, b_s):
    b, l, _ = u.shape
    vn = layer_norm(v, ln_g, ln_b).reshape(b, l // CHUNK, CHUNK, GM_GROUPS, GM_GROUP_DIM)
    s = jnp.einsum('gij,bnjgc->bnigc', w_s, vn) + b_s.T[:, :, None]
    return u * s.reshape(b, l, GM_WIDTH)


def token_mix(p, k_nope, k_rope, v, rope, q_norm, w_uq, gm_ln_g, gm_ln_b, gm_ws, gm_bs,
              w_proj_a, w_proj_b, b_merge, w_out):
    q_nope, q_rope = mla_q(p[..., OFF_Q:OFF_KV], q_norm, w_uq, rope)
    att = blocked_attend(q_nope, q_rope, k_nope, k_rope, v)
    z = jax.nn.gelu(p[..., :2 * GM_WIDTH])
    gm = chunk_gmlp(z[..., :GM_WIDTH], z[..., GM_WIDTH:], gm_ln_g, gm_ln_b, gm_ws, gm_bs)
    gates = jax.nn.sigmoid(p[..., OFF_G:] + b_merge)
    y = (gates[..., :D_MODEL] * (gm @ w_proj_a)
         + gates[..., D_MODEL:] * (att.reshape(*att.shape[:2], N_HEADS * V_HEAD) @ w_proj_b))
    return y @ w_out


def moe(h, w_router, b_router, w_gate, w_up, w_down):
    shp = h.shape
    hf = h.reshape(-1, D_MODEL)
    t = hf.shape[0]
    aff = jax.nn.sigmoid((hf @ w_router).astype(jnp.float32))
    sel = (aff + b_router.astype(jnp.float32)).reshape(t, N_EXPERT_GROUPS, EXPERTS_PER_GROUP)
    group_score = lax.top_k(sel, TOP_K)[0].sum(-1)
    grp = jnp.argmax(group_score, axis=-1)
    sel_in = jnp.take_along_axis(sel, grp[:, None, None], axis=1)[:, 0]
    _, idx = lax.top_k(sel_in, TOP_K)
    expert = grp[:, None] * EXPERTS_PER_GROUP + idx
    wts = jnp.take_along_axis(aff, expert, axis=1)
    wts = wts / wts.sum(-1, keepdims=True)
    flat_e = expert.reshape(-1)
    n_assign = flat_e.shape[0]
    order = jnp.argsort(flat_e)
    e_sorted = flat_e[order]
    tok = order // TOP_K
    sizes = jnp.bincount(flat_e, length=N_EXPERTS)
    starts = jnp.cumsum(sizes) - sizes
    padded = (sizes + MOE_BLOCK - 1) // MOE_BLOCK * MOE_BLOCK
    pad_ends = jnp.cumsum(padded)
    pad_starts = pad_ends - padded
    dest = pad_starts[e_sorted] + jnp.arange(n_assign) - starts[e_sorted]
    n_blocks = -(-(n_assign + N_EXPERTS * (MOE_BLOCK - 1)) // MOE_BLOCK)
    buf = jnp.zeros((n_blocks * MOE_BLOCK, D_MODEL), h.dtype).at[dest].set(hf[tok])
    blk_expert = jnp.minimum(
        jnp.searchsorted(pad_ends, jnp.arange(n_blocks) * MOE_BLOCK, side='right'), N_EXPERTS - 1)

    def expert_ffn(args):
        xb, e = args
        return (jax.nn.silu(xb @ w_gate[e]) * (xb @ w_up[e])) @ w_down[e]

    out = lax.map(expert_ffn, (buf.reshape(n_blocks, MOE_BLOCK, D_MODEL), blk_expert)).reshape(-1, D_MODEL)
    contrib = out[dest] * wts.reshape(-1)[order][:, None].astype(h.dtype)
    return jax.ops.segment_sum(contrib, tok, num_segments=t).reshape(shp)


def setup_inputs(seed: int = 0) -> dict:
    key = jax.random.key(seed)
    ks = iter(jax.random.split(key, 32))

    def nrm(shape, scale):
        return jax.random.normal(next(ks), shape, jnp.float32) * scale

    D, L = D_MODEL, DEPTH
    return {
        "x": nrm((BATCH, SEQ, D), 1.0),
        "c": nrm((BATCH, D), 1.0),
        "ctx": nrm((BATCH, CTX_LEN, D), 1.0),
        "c_ctx": nrm((D,), 1.0),
        "w_ada": nrm((L, D, 6 * D), 0.5 * D ** -0.5),
        "b_ada": nrm((L, 6 * D), 0.02),
        "w_in": nrm((L, D, IN_COLS), D ** -0.5),
        "gm_ln_g": 1.0 + nrm((L, GM_WIDTH), 0.02),
        "gm_ln_b": nrm((L, GM_WIDTH), 0.02),
        "gm_ws": nrm((L, GM_GROUPS, CHUNK, CHUNK), CHUNK ** -0.5),
        "gm_bs": 1.0 + nrm((L, GM_GROUPS, CHUNK), 0.02),
        "q_norm": 1.0 + nrm((L, Q_LORA), 0.02),
        "w_uq": nrm((L, Q_LORA, N_HEADS * (QK_NOPE + QK_ROPE)), Q_LORA ** -0.5),
        "kv_norm": 1.0 + nrm((L, KV_LORA), 0.02),
        "w_ukv": nrm((L, KV_LORA, N_HEADS * (QK_NOPE + V_HEAD)), KV_LORA ** -0.5),
        "w_proj_a": nrm((L, GM_WIDTH, D), GM_WIDTH ** -0.5),
        "w_proj_b": nrm((L, N_HEADS * V_HEAD, D), (N_HEADS * V_HEAD) ** -0.5),
        "b_merge": nrm((L, 2 * D), 0.02),
        "w_out": nrm((L, D, D), BETA * D ** -0.5),
        "ln1_g": 1.0 + nrm((L, D), 0.02),
        "ln1_b": nrm((L, D), 0.02),
        "w_router": nrm((D, N_EXPERTS), D ** -0.5),
        "b_router": nrm((N_EXPERTS,), 0.01),
        "w_e_gate": nrm((L, N_EXPERTS, D, D_EXPERT), D ** -0.5),
        "w_e_up": nrm((L, N_EXPERTS, D, D_EXPERT), D ** -0.5),
        "w_e_down": nrm((L, N_EXPERTS, D_EXPERT, D), BETA * D_EXPERT ** -0.5),
        "ln2_g": 1.0 + nrm((L, D), 0.02),
        "ln2_b": nrm((L, D), 0.02),
    }


def reference(x, c, ctx, c_ctx, w_ada, b_ada, w_in, gm_ln_g, gm_ln_b, gm_ws, gm_bs, q_norm, w_uq,
              kv_norm, w_ukv, w_proj_a, w_proj_b, b_merge, w_out, ln1_g, ln1_b, w_router, b_router,
              w_e_gate, w_e_up, w_e_down, ln2_g, ln2_b):
    ctx_len = ctx.shape[1]
    rope = axial_rope(x.shape[1], x.dtype)
    lat, cx = x, ctx
    for l in range(DEPTH):
        last = l == DEPTH - 1
        mod = jax.nn.silu(c) @ w_ada[l] + b_ada[l]
        mod_c = jax.nn.silu(c_ctx) @ w_ada[l] + b_ada[l]
        sh1, sc1, g1, sh2, sc2, g2 = jnp.split(mod[:, None, :], 6, axis=-1)
        csh1, csc1, cg1, csh2, csc2, cg2 = jnp.split(mod_c, 6)
        mix_w = (q_norm[l], w_uq[l], gm_ln_g[l], gm_ln_b[l], gm_ws[l], gm_bs[l],
                 w_proj_a[l], w_proj_b[l], b_merge[l], w_out[l])

        hc = cx * (1 + csc1) + csh1
        if last:
            pc_kv = hc @ w_in[l][:, OFF_KV:OFF_G]
        else:
            pc = hc @ w_in[l]
            pc_kv = pc[..., OFF_KV:OFF_G]
        ck_nope, ck_rope, cv = mla_kv(pc_kv, kv_norm[l], w_ukv[l], None)

        h = lat * (1 + sc1) + sh1
        p = h @ w_in[l]
        k_nope, k_rope, v = mla_kv(p[..., OFF_KV:OFF_G], kv_norm[l], w_ukv[l], rope)
        mix = token_mix(p,
                        jnp.concatenate([ck_nope, k_nope], axis=1),
                        jnp.concatenate([ck_rope, k_rope], axis=1),
                        jnp.concatenate([cv, v], axis=1),
                        rope, *mix_w)
        lat = layer_norm(ALPHA * lat + g1 * mix, ln1_g[l], ln1_b[l])

        h2 = lat * (1 + sc2) + sh2
        if last:
            f = moe(h2, w_router, b_router, w_e_gate[l], w_e_up[l], w_e_down[l])
        else:
            cmix = token_mix(pc, ck_nope, ck_rope, cv, None, *mix_w)
            cx = layer_norm(ALPHA * cx + cg1 * cmix, ln1_g[l], ln1_b[l])
            hc2 = cx * (1 + csc2) + csh2
            f_all = moe(jnp.concatenate([hc2, h2], axis=1), w_router, b_router,
                        w_e_gate[l], w_e_up[l], w_e_down[l])
            cx = layer_norm(ALPHA * cx + cg2 * f_all[:, :ctx_len], ln2_g[l], ln2_b[l])
            f = f_all[:, ctx_len:]
        lat = layer_norm(ALPHA * lat + g2 * f, ln2_g[l], ln2_b[l])
    return lat
```

```cpp
#include <hip/hip_runtime.h>
#include <cstdio>
#include <cstdint>
#include <cstddef>

#define LAS __attribute__((address_space(3)))
#define GAS __attribute__((address_space(1)))
typedef unsigned short bf16_t;
typedef short bf16x8 __attribute__((ext_vector_type(8)));
typedef short s16x4 __attribute__((ext_vector_type(4)));
typedef float f32x2 __attribute__((ext_vector_type(2)));
typedef float f32x4 __attribute__((ext_vector_type(4)));
typedef float f32x16 __attribute__((ext_vector_type(16)));
typedef unsigned u32x2 __attribute__((ext_vector_type(2)));
typedef unsigned u32x4 __attribute__((ext_vector_type(4)));

constexpr int DM = 1024, NB = 32, SEQ = 2048, DEPTH = 2, CTX = 256, RPB = CTX + SEQ;
constexpr int NH = 8, QLORA = 384, KVLORA = 256, NE = 16, DE = 512;
constexpr int OFF_Q = 2048, OFF_KV = 2432, OFF_KR = 2688, OFF_G = 2752, IN_COLS = 4800;
constexpr int NIN = 4864;
constexpr int NMID = 768;
constexpr float LN_EPS = 1e-5f, ALPHA = 1.4142135623730951f;
constexpr int NG = 2, GB = NB / NG, TG = GB * RPB, NPAN = TG / 256;
#ifndef DBG_STOP
#define DBG_STOP 0
#endif
#ifndef DBG_FILL
#define DBG_FILL 0
#endif
#ifndef DBG_NOMOE
#define DBG_NOMOE 0
#endif
#ifndef DBG_NOMIX
#define DBG_NOMIX 0
#endif
#ifndef DBG_GM
#define DBG_GM 0
#endif
#ifndef DBG_NOGMB
#define DBG_NOGMB 0
#endif
#ifndef DBG_GA1
#define DBG_GA1 0
#endif
#ifndef DBG_COL0
#define DBG_COL0 0
#endif
#ifndef DBG_SEL
#define DBG_SEL 0
#endif
#ifndef DBG_REP
#define DBG_REP 100
#endif
#define REPS(k) for (int rep_ = 0; rep_ < ((DBG_REP == (k)) ? 2 : 1); ++rep_)
#ifndef DBG_EPI2
#define DBG_EPI2 0
#endif
#ifndef DBG_K2
#define DBG_K2 0
#endif
#ifndef DBG_NOATT
#define DBG_NOATT 0
#endif
#ifndef DBG_MIXSCALE
#define DBG_MIXSCALE 1.0f
#endif
constexpr int NT = 512;
constexpr int WGSTR = 320;
#ifndef MK_MASK
#define MK_MASK 0xFFFFu
#endif
#define PH(k) ((MK_MASK >> (k)) & 1u)

constexpr size_t al256(size_t x) { return (x + 255) / 256 * 256; }
constexpr size_t WS_CTL  = 0;
constexpr size_t CTL_BYTES = 65536;
constexpr size_t WS_MOD  = WS_CTL + CTL_BYTES;
constexpr size_t WS_ROPE = WS_MOD + al256((size_t)2 * 33 * 6144 * 4);
constexpr size_t WS_WIN  = WS_ROPE + (size_t)2 * 2048 * 32 * 4;
constexpr size_t WS_WUQ  = WS_WIN + (size_t)2 * NIN * 1024 * 2;
constexpr size_t WS_WUKV = WS_WUQ + (size_t)2 * 1536 * 384 * 2;
constexpr size_t WS_WPA  = WS_WUKV + (size_t)2 * 2048 * 256 * 2;
constexpr size_t WS_WPB  = WS_WPA + (size_t)2 * 1024 * 1024 * 2;
constexpr size_t WS_WO   = WS_WPB + (size_t)2 * 1024 * 1024 * 2;
constexpr size_t WS_WGU  = WS_WO + (size_t)2 * 1024 * 1024 * 2;
constexpr size_t WS_WD   = WS_WGU + (size_t)2 * 16 * 1024 * 1024 * 2;
constexpr size_t WS_WS   = WS_WD + (size_t)2 * 16 * 1024 * 512 * 2;
constexpr size_t WS_LIST = WS_WS + (size_t)2 * 8 * 128 * 128 * 2;
constexpr size_t WS_WT   = WS_LIST + (size_t)16 * TG * 4;
constexpr size_t WS_LAT  = WS_WT + (size_t)1048576;
constexpr size_t WS_H    = WS_LAT + (size_t)TG * 1024 * 2;
constexpr size_t WS_Z    = WS_H + (size_t)TG * 1024 * 2;
constexpr size_t WS_GT   = WS_Z + (size_t)TG * 2048 * 2;
constexpr size_t WS_MID  = WS_GT + (size_t)TG * 2048 * 2;
constexpr size_t WS_KV   = WS_MID + (size_t)TG * NMID * 4;
constexpr size_t WS_GM   = WS_KV + (size_t)TG * 2048 * 2;
constexpr size_t WS_END  = WS_GM + (size_t)TG * 1024 * 2;
constexpr size_t WS_QN   = WS_H;
constexpr size_t WS_KVN  = WS_QN + (size_t)TG * 512;
constexpr size_t WS_KR   = WS_KVN + (size_t)TG * 256;
static_assert(WS_KR + (size_t)TG * 64 * 2 <= WS_Z, "alias overflow");
static_assert(TG % 32 == 0, "P2a works on 32-row blocks");
static_assert(NPAN % 8 == 0 && (GB * 8) % 8 == 0, "DenseOrder assumes whole groups of 8 row panels");
constexpr int CW_BAR = 0;
constexpr int CW_CNT = 4096;

#define XB_TMO      128
#define XB_XCNT(j)  (256  + 64 * (j))
#define XB_XSUB(j)  (1280 + 64 * (j))
#define XB_XGEN(j)  (2304 + 64 * (j))
#define XB_TOP      3328
#define XB_TOPGEN   3392
#define XCD_BAR_WORDS 3456
#define XB_SPIN_CAP (1u << 23)
__device__ __forceinline__ unsigned xb_ld(unsigned* p)              { return __hip_atomic_load(p, __ATOMIC_RELAXED, __HIP_MEMORY_SCOPE_AGENT); }
__device__ __forceinline__ unsigned xb_add(unsigned* p, unsigned v) { return __hip_atomic_fetch_add(p, v, __ATOMIC_RELAXED, __HIP_MEMORY_SCOPE_AGENT); }
__device__ __forceinline__ unsigned xb_xcc_id() { return (unsigned)__builtin_amdgcn_s_getreg((3 << 11) | 20) & 0xFu; }
#define XB_SPIN(cond, bar) do { unsigned _sp = 0; while (cond) { __builtin_amdgcn_s_sleep(1); \
    if ((++_sp & 255u) == 0u) { if (xb_ld(&(bar)[XB_TMO])) break; if (_sp > XB_SPIN_CAP) { atomicAdd(&(bar)[XB_TMO], 1u); break; } } } } while (0)
struct XcdBarrier { unsigned* bar; unsigned x; volatile LAS unsigned* st; };
__device__ __forceinline__ XcdBarrier xcd_barrier_post(unsigned* bar, volatile LAS unsigned* st) {
    XcdBarrier b; b.bar = bar; b.x = xb_xcc_id(); b.st = st;
    if (threadIdx.x == 0) (void)xb_add(&bar[XB_XCNT(b.x)], 1u);
    return b;
}
__device__ __forceinline__ void xcd_barrier_complete(unsigned* bar, unsigned x, unsigned& nloc, unsigned& nx) {
    const unsigned G = gridDim.x * gridDim.y * gridDim.z;
    unsigned sum, cnt, mine, sp = 0u;
    for (;;) {
        sum = 0u; cnt = 0u; mine = 0u;
#pragma unroll
        for (unsigned j = 0; j < 16; ++j) { const unsigned c = xb_ld(&bar[XB_XCNT(j)]); sum += c; cnt += (c > 0u) ? 1u : 0u; mine = (j == x) ? c : mine; }
        if (sum == G) break;
        __builtin_amdgcn_s_sleep(1);
        if ((++sp & 255u) == 0u) { if (xb_ld(&bar[XB_TMO])) break; if (sp > XB_SPIN_CAP) { atomicAdd(&bar[XB_TMO], 1u); break; } }
    }
    nloc = mine > 0u ? mine : 1u; nx = cnt > 0u ? cnt : 1u;
}
__device__ __forceinline__ void xcd_barrier(const XcdBarrier& b, int tid0) {
    asm volatile("s_waitcnt vmcnt(0)" ::: "memory");
    __syncthreads();
    if (tid0 == 0) {
        GAS unsigned* barg_ = (GAS unsigned*)b.bar; unsigned bx = b.x;
        asm volatile("" : "+s"(barg_), "+s"(bx));
        unsigned* bar = (unsigned*)barg_;
        __builtin_amdgcn_s_waitcnt(0);
        unsigned nloc = b.st[0], nx = b.st[1];
        if (nloc == 0u) { xcd_barrier_complete(bar, bx, nloc, nx); b.st[0] = nloc; b.st[1] = nx; }
        const unsigned old = xb_add(&bar[XB_XSUB(bx)], 1u);
        const unsigned gen = old / nloc;
        if (old + 1u == (gen + 1u) * nloc) {
            __builtin_amdgcn_fence(__ATOMIC_RELEASE, "agent");
            asm volatile("s_waitcnt vmcnt(0)" ::: "memory");
            const unsigned og = xb_add(&bar[XB_TOP], 1u);
            const unsigned tg = og / nx;
            if (og + 1u == (tg + 1u) * nx) xb_add(&bar[XB_TOPGEN], 1u);
            else XB_SPIN(xb_ld(&bar[XB_TOPGEN]) == tg, bar);
            __builtin_amdgcn_fence(__ATOMIC_ACQUIRE, "agent");
            xb_add(&bar[XB_XGEN(bx)], 1u);
            asm volatile("s_waitcnt vmcnt(0)" ::: "memory");
        } else {
            XB_SPIN(xb_ld(&bar[XB_XGEN(bx)]) == gen, bar);
            __builtin_amdgcn_fence(__ATOMIC_ACQUIRE, "agent");
            asm volatile("s_waitcnt vmcnt(0)" ::: "memory");
        }
    }
    __syncthreads();
}

typedef __bf16 bf16x2_t __attribute__((ext_vector_type(2)));
__device__ __forceinline__ unsigned cvt_pk_bf16(float lo, float hi) { f32x2 v = {lo, hi}; bf16x2_t r = __builtin_convertvector(v, bf16x2_t); return __builtin_bit_cast(unsigned, r); }
__device__ __forceinline__ unsigned cvt_pk4_fp8(float a, float b, float c, float d) { int w = 0; w = __builtin_amdgcn_cvt_pk_fp8_f32(a, b, w, false); w = __builtin_amdgcn_cvt_pk_fp8_f32(c, d, w, true); return (unsigned)w; }
__device__ __forceinline__ f32x4 fp8x4_f32(unsigned w) { const f32x2 a = __builtin_amdgcn_cvt_pk_f32_fp8((int)w, false), b = __builtin_amdgcn_cvt_pk_f32_fp8((int)w, true); return (f32x4){a[0], a[1], b[0], b[1]}; }
__device__ __forceinline__ bf16_t f2bf(float f) { return (bf16_t)(cvt_pk_bf16(f, 0.f) & 0xffffu); }
__device__ __forceinline__ float bf_lo(unsigned w) { return __uint_as_float(w << 16); }
__device__ __forceinline__ float bf_hi(unsigned w) { return __uint_as_float(w & 0xffff0000u); }
__device__ __forceinline__ float fsigmoid(float x) { return __builtin_amdgcn_rcpf(1.0f + __builtin_amdgcn_exp2f(-1.4426950408889634f * x)); }
__device__ __forceinline__ float gelu_tanh(float x) { const float u = 1.5957691216057308f * (x + 0.044715f * x * x * x); return x * fsigmoid(u); }
__device__ __forceinline__ f32x4 gelu4_a32(f32x4 a) { const f32x4 t = a * a; const f32x4 p = t * (-3.14157838e-6f) + (-0.0719440062f); const f32x4 arg = a * p; f32x4 e;
#pragma unroll
    for (int j = 0; j < 4; ++j) e[j] = __builtin_amdgcn_exp2f(arg[j]);
    const f32x4 d = e * 32.0f + 32.0f; f32x4 r;
#pragma unroll
    for (int j = 0; j < 4; ++j) r[j] = __builtin_amdgcn_rcpf(d[j]);
    return a * r; }
__device__ __forceinline__ f32x4 sigmoid4_a32(f32x4 a, f32x4 nb) { const f32x4 arg = a * (-0.0450842200f) + nb; f32x4 r;
#pragma unroll
    for (int j = 0; j < 4; ++j) r[j] = __builtin_amdgcn_rcpf(1.0f + __builtin_amdgcn_exp2f(arg[j]));
    return r; }
template <int N> __device__ __forceinline__ float row_ror(float x) { return __uint_as_float((unsigned)__builtin_amdgcn_update_dpp(0, (int)__float_as_uint(x), 0x120 + N, 0xf, 0xf, false)); }
__device__ __forceinline__ float row_sum16(float x) { x += row_ror<8>(x); x += row_ror<4>(x); x += row_ror<2>(x); x += row_ror<1>(x); return x; }
__device__ __forceinline__ float wave_sum(float x) { x = row_sum16(x);
    { auto r = __builtin_amdgcn_permlane16_swap(__float_as_uint(x), __float_as_uint(x), false, false); x = __uint_as_float(r[0]) + __uint_as_float(r[1]); }
    { auto r = __builtin_amdgcn_permlane32_swap(__float_as_uint(x), __float_as_uint(x), false, false); x = __uint_as_float(r[0]) + __uint_as_float(r[1]); }
    return x; }
__device__ __forceinline__ void reduce16_rows(const float (&x)[16], float (&z)[4]) {
    float y[8];
#pragma unroll
    for (int k = 0; k < 8; ++k) { auto r = __builtin_amdgcn_permlane32_swap(__float_as_uint(x[k]), __float_as_uint(x[k + 8]), false, false); y[k] = __uint_as_float(r[0]) + __uint_as_float(r[1]); }
#pragma unroll
    for (int k = 0; k < 4; ++k) { auto r = __builtin_amdgcn_permlane16_swap(__float_as_uint(y[k]), __float_as_uint(y[k + 4]), false, false); z[k] = row_sum16(__uint_as_float(r[0]) + __uint_as_float(r[1])); }
}
__device__ __forceinline__ float bcast_entry(const float (&z)[4], int e) { return __uint_as_float((unsigned)__builtin_amdgcn_readlane((int)__float_as_uint(z[e & 3]), (e >> 2) * 16)); }
__host__ __device__ __forceinline__ int rope_orig(int p) { const int b = p >> 3, j = p & 7; return (j < 4) ? (4 * b + j) : (32 + 4 * b + (j - 4)); }

struct Params { const float* in[28]; float* out; unsigned char* ws; };
enum { I_X = 0, I_C, I_CTX, I_CCTX, I_WADA, I_BADA, I_WIN, I_GMLNG, I_GMLNB, I_GMWS, I_GMBS, I_QNORM, I_WUQ, I_KVNORM, I_WUKV, I_WPA, I_WPB, I_BMERGE, I_WOUT,
       I_LN1G, I_LN1B, I_WROUTER, I_BROUTER, I_WEG, I_WEU, I_WED, I_LN2G, I_LN2B };

__device__ __forceinline__ int row_mod(int r, int g) { const int bl = r / RPB, rr = r - bl * RPB; return rr < CTX ? 32 : g * GB + bl; }

namespace pg8 {
constexpr int BM = 256, BK = 64, HALF = 128, HTB = HALF * BK * 2, STAGE_BYTES = 8 * HTB, NXCD = 8, WGM = 8;
__host__ __device__ __forceinline__ int lds_byte(int r, int c) { const int st = (r >> 4) * 2 + (c >> 5), rr = r & 15, cc = c & 31, ob = rr * 64 + cc * 2; return st * 1024 + (ob ^ (((ob >> 9) & 1) << 5)); }
__host__ __device__ __forceinline__ void stage_rc(int b, int& R, int& C) { const int st = b / 1024, sb = b % 1024, swz = sb ^ (((sb >> 9) & 1) << 5); R = (st >> 1) * 16 + swz / 64; C = (st & 1) * 32 + (swz % 64) / 2; }
__host__ __device__ __forceinline__ int perm32(int rho) { const int n = rho >> 4, i = rho & 15; return 8 * (i >> 2) + 4 * n + (i & 3); }

struct Unit { int pm, pn, bt, aux; };
struct Gemm { const unsigned char* A; const bf16_t* Bt; int K; };

struct DenseOrder {
    static constexpr bool GATHER = false;
    int nM, nN, nwg, G, c, latmap, ext_n, ext_pn0, ntot; float rnig;
    __device__ void init(int nM_, int nN_, int G_, int c_, int latmap_ = 0, int ext_n_ = 0, int ext_pn0_ = 0) { nM = nM_; nN = nN_; nwg = nM * nN; G = G_; c = c_; latmap = latmap_; ext_n = ext_n_; ext_pn0 = ext_pn0_; ntot = nwg + GB * ext_n; rnig = 1.0f / (float)(WGM * nN); }
    __device__ __forceinline__ bool next(int i, Unit& u) const {
        const long L = (long)i * G + c; if (L >= ntot) return false;
        u.aux = 0;
        if (L >= nwg) { const int idx = (int)L - nwg; u.pm = (idx / ext_n) * 9; u.pn = ext_pn0 + idx % ext_n; u.bt = u.pn; return true; }
        int wgid = (int)L; { const int q = nwg / NXCD, r = nwg % NXCD, xcd = wgid % NXCD, off = wgid / NXCD; wgid = (xcd < r ? xcd * (q + 1) : r * (q + 1) + (xcd - r) * q) + off; }
        const int nig = WGM * nN, gid = (int)(((float)wgid + 0.5f) * rnig), within = wgid - gid * nig;
        int pm = gid * WGM + (within & (WGM - 1)); if (latmap) pm = (pm >> 3) * 9 + 1 + (pm & 7);
        u.pm = pm; u.pn = within >> 3; u.bt = u.pn; return true;
    }
    __device__ __forceinline__ unsigned arow(const Unit& u, int r) const { return (unsigned)(u.pm * BM + r); }
};

typedef int i32x8 __attribute__((ext_vector_type(8)));
template <class Epi, class Sched, bool FP8 = false>
__device__ __forceinline__ void gemm_phase(LAS unsigned char* lds, const Gemm g, const Sched& S, const Epi& E, int tid_in) {
    constexpr bool GA = Sched::GATHER;
    int tid = tid_in; asm volatile("" : "+v"(tid));
    const int wid = __builtin_amdgcn_readfirstlane(tid >> 6), lane = tid & 63, wr = wid >> 2, wc = wid & 3, fr = lane & 15, fq = lane >> 4;
    int K = g.K; asm volatile("" : "+s"(K));
    const int nt = K / BK;
    const unsigned rowB = (unsigned)K * 2u;
    unsigned voffA0, voffA1, voffB0, voffB1;
    { int R, C; stage_rc(tid * 16, R, C); voffA0 = (unsigned)(R * K + C) * 2u; voffB0 = (unsigned)(((R & ~31) + perm32(R & 31)) * K + C) * 2u;
      stage_rc(tid * 16 + 8192, R, C); voffA1 = (unsigned)(R * K + C) * 2u; voffB1 = (unsigned)(((R & ~31) + perm32(R & 31)) * K + C) * 2u; }
    const size_t kstep = (size_t)(BK * 2);
    const size_t hstep = (size_t)HALF * K * 2;
    const size_t tstep = 2 * hstep;
    const unsigned ldsw = (unsigned)wid * 1024u;
    const int aoff = lds_byte(wr * 64 + fr, fq * 8), boff = lds_byte(wc * 32 + fr, fq * 8);
#define PG8_SA(b, h) (((b) * 2 + (h)) * HTB)
#define PG8_SB(b, h) ((4 + (b) * 2 + (h)) * HTB)
#define PG8_STAGE(bufoff, gbase, v0, v1) do { \
        __builtin_amdgcn_global_load_lds((const unsigned*)((const char*)(gbase) + (v0)), (LAS unsigned*)(lds + (bufoff) + ldsw), 16, 0, 0); \
        __builtin_amdgcn_global_load_lds((const unsigned*)((const char*)(gbase) + (v1)), (LAS unsigned*)(lds + (bufoff) + ldsw + 8192), 16, 0, 0); } while (0)
#define PG8_STG1(bufoff, gbase, v0) __builtin_amdgcn_global_load_lds((const unsigned*)((const char*)(gbase) + (v0)), (LAS unsigned*)(lds + (bufoff) + ldsw), 16, 0, 0)
#define PG8_STG2(bufoff, gbase, v1) __builtin_amdgcn_global_load_lds((const unsigned*)((const char*)(gbase) + (v1)), (LAS unsigned*)(lds + (bufoff) + ldsw + 8192), 16, 0, 0)
#define PG8_STGA1(bufoff, ptr, h) do { if constexpr (GA) { PG8_STG1(bufoff, ptr, (h) ? c10 : c00); } else { PG8_STG1(bufoff, (ptr) + ((h) ? hstep : (size_t)0), voffA0); } } while (0)
#define PG8_STGA2(bufoff, ptr, h) do { if constexpr (GA) { PG8_STG2(bufoff, ptr, (h) ? c11 : c01); } else { PG8_STG2(bufoff, (ptr) + ((h) ? hstep : (size_t)0), voffA1); } } while (0)
#define PG8_STAGE_A(bufoff, ptr, h) do { if constexpr (GA) { PG8_STAGE(bufoff, ptr, (h) ? c10 : c00, (h) ? c11 : c01); } else { PG8_STAGE(bufoff, (ptr) + ((h) ? hstep : (size_t)0), voffA0, voffA1); } } while (0)
#define PG8_LD8(dst, idx, addr) do { const u32x4 lo_ = *(const LAS u32x4*)(addr), hi_ = *(const LAS u32x4*)((addr) + 1024); dst[idx] = (i32x8){(int)lo_.x, (int)lo_.y, (int)lo_.z, (int)lo_.w, (int)hi_.x, (int)hi_.y, (int)hi_.z, (int)hi_.w}; } while (0)
#define PG8_LDA(dst, b, h) do { _Pragma("unroll") for (int m = 0; m < 4; ++m) PG8_LD8(dst, m, lds + PG8_SA(b, h) + aoff + m * 2048); } while (0)
#define PG8_LDB(dst, b, h) do { _Pragma("unroll") for (int n = 0; n < 2; ++n) PG8_LD8(dst, n, lds + PG8_SB(b, h) + boff + n * 2048); } while (0)
#define PG8_HALF(v, k) __builtin_bit_cast(bf16x8, (k) ? __builtin_shufflevector(v, v, 4, 5, 6, 7) : __builtin_shufflevector(v, v, 0, 1, 2, 3))
#define PG8_MMA(ai, bj, At, Bt) do { __builtin_amdgcn_s_setprio(1); _Pragma("unroll") for (int m = 0; m < 4; ++m) _Pragma("unroll") for (int n = 0; n < 2; ++n) { \
        if constexpr (FP8) asm volatile("v_mfma_scale_f32_16x16x128_f8f6f4 %0, %1, %2, %0, %3, %3 op_sel_hi:[0,0,0]" : "+v"(acc[ai][bj][m][n]) : "v"(Bt[n]), "v"(At[m]), "v"(one_scale));   \
        else { acc[ai][bj][m][n] = __builtin_amdgcn_mfma_f32_16x16x32_bf16(PG8_HALF(Bt[n], 0), PG8_HALF(At[m], 0), acc[ai][bj][m][n], 0, 0, 0); \
               acc[ai][bj][m][n] = __builtin_amdgcn_mfma_f32_16x16x32_bf16(PG8_HALF(Bt[n], 1), PG8_HALF(At[m], 1), acc[ai][bj][m][n], 0, 0, 0); } } \
        __builtin_amdgcn_s_setprio(0); } while (0)
#define PG8_ZERO(ai, bj) do { if (t == 0) { _Pragma("unroll") for (int m = 0; m < 4; ++m) _Pragma("unroll") for (int n = 0; n < 2; ++n) acc[ai][bj][m][n] = (f32x4){0.f, 0.f, 0.f, 0.f}; } } while (0)
#define PG8_WAIT_V(n) asm volatile("s_waitcnt vmcnt(" #n ")" ::: "memory")
#define PG8_WAIT_L(n) asm volatile("s_waitcnt lgkmcnt(" #n ")" ::: "memory")
#define PG8_BAR __builtin_amdgcn_s_barrier()
#define PG8_SCHED __builtin_amdgcn_sched_barrier(0)
#define PG8_AOFF(d00, d01, d10, d11, u) do { int _R0, _C0, _R1, _C1; stage_rc(tid * 16, _R0, _C0); stage_rc(tid * 16 + 8192, _R1, _C1); \
        d00 = S.arow(u, _R0) * rowB + (unsigned)_C0 * 2u; d01 = S.arow(u, _R1) * rowB + (unsigned)_C1 * 2u; \
        d10 = S.arow(u, HALF + _R0) * rowB + (unsigned)_C0 * 2u; d11 = S.arow(u, HALF + _R1) * rowB + (unsigned)_C1 * 2u; } while (0)
    Unit cur, nxt; int ui = 0;
    if (!S.next(0, cur)) return;
    f32x4 acc[2][2][4][2];
    i32x8 At[4], B0[2], B1[2];
    int one_scale = 0x7f7f7f7f; asm volatile("" : "+v"(one_scale));
    unsigned c00 = 0, c01 = 0, c10 = 0, c11 = 0, n00 = 0, n01 = 0, n10 = 0, n11 = 0;
    if constexpr (GA) PG8_AOFF(c00, c01, c10, c11, cur);
    const char* cA = (const char*)g.A + (GA ? (size_t)0 : (size_t)S.arow(cur, 0) * rowB); const char* cB = (const char*)g.Bt + (size_t)cur.bt * tstep;
    PG8_STAGE(PG8_SB(0, 0), cB, voffB0, voffB1); PG8_STAGE_A(PG8_SA(0, 0), cA, 0); PG8_STAGE(PG8_SB(0, 1), cB + hstep, voffB0, voffB1); PG8_STAGE_A(PG8_SA(0, 1), cA, 1);
    if (wr == 1) PG8_BAR;
    PG8_WAIT_V(4); PG8_BAR;
    PG8_STAGE(PG8_SB(1, 0), cB + kstep, voffB0, voffB1); PG8_STAGE_A(PG8_SA(1, 0), cA + kstep, 0); PG8_STAGE(PG8_SB(1, 1), cB + hstep + kstep, voffB0, voffB1);
    PG8_WAIT_V(6); PG8_BAR;
    for (;;) {
        const bool has_next = S.next(DBG_K2 ? (ui + 1) >> 1 : ui + 1, nxt);
        if constexpr (GA) { if (has_next) { PG8_AOFF(n00, n01, n10, n11, nxt); } else { n00 = c00; n01 = c01; n10 = c10; n11 = c11; } }
        const char* nA = (GA || !has_next) ? cA : (const char*)g.A + (size_t)S.arow(nxt, 0) * rowB;
        const char* nB = has_next ? (const char*)g.Bt + (size_t)nxt.bt * tstep : cB;
        for (int t = 0; t < nt; t += 2) {
            const bool last = (t == nt - 2);
            const char* a1 = cA + (size_t)(t + 1) * kstep;
            const char* a2 = last ? nA : cA + (size_t)(t + 2) * kstep; const char* b2 = last ? nB : cB + (size_t)(t + 2) * kstep;
            const char* a3 = a2 + kstep; const char* b3 = b2 + kstep;
            PG8_LDB(B0, 0, 0); PG8_SCHED; PG8_LDA(At, 0, 0); PG8_STGA1(PG8_SA(1, 1), a1, 1);
            PG8_WAIT_L(8); PG8_BAR; PG8_ZERO(0, 0); PG8_WAIT_L(0); PG8_MMA(0, 0, At, B0); PG8_STGA2(PG8_SA(1, 1), a1, 1);
            if constexpr (GA) { if (last) { c00 = n00; c01 = n01; c10 = n10; c11 = n11; } }
            PG8_BAR; PG8_SCHED;
            PG8_LDB(B1, 0, 1); PG8_STG1(PG8_SB(0, 0), b2, voffB0);
            PG8_BAR; PG8_ZERO(0, 1); PG8_WAIT_L(0); PG8_MMA(0, 1, At, B1); PG8_STG2(PG8_SB(0, 0), b2, voffB1); PG8_BAR;
            PG8_LDA(At, 0, 1); PG8_STGA1(PG8_SA(0, 0), a2, 0);
            PG8_BAR; PG8_ZERO(1, 0); PG8_WAIT_L(0); PG8_MMA(1, 0, At, B0); PG8_STGA2(PG8_SA(0, 0), a2, 0); PG8_BAR; PG8_SCHED;
            PG8_STG1(PG8_SB(0, 1), b2 + hstep, voffB0);
            PG8_WAIT_V(5); PG8_BAR; PG8_ZERO(1, 1); PG8_MMA(1, 1, At, B1); PG8_STG2(PG8_SB(0, 1), b2 + hstep, voffB1); PG8_BAR;
            PG8_LDB(B0, 1, 0); PG8_SCHED; PG8_LDA(At, 1, 0); PG8_STGA1(PG8_SA(0, 1), a2, 1);
            PG8_WAIT_L(8); PG8_BAR; PG8_WAIT_L(0); PG8_MMA(0, 0, At, B0); PG8_STGA2(PG8_SA(0, 1), a2, 1); PG8_BAR; PG8_SCHED;
            PG8_LDB(B1, 1, 1); PG8_STG1(PG8_SB(1, 0), b3, voffB0);
            PG8_BAR; PG8_WAIT_L(0); PG8_MMA(0, 1, At, B1); PG8_STG2(PG8_SB(1, 0), b3, voffB1); PG8_BAR;
            PG8_LDA(At, 1, 1); PG8_STGA1(PG8_SA(1, 0), a3, 0);
            PG8_BAR; PG8_WAIT_L(0); PG8_MMA(1, 0, At, B0); PG8_STGA2(PG8_SA(1, 0), a3, 0); PG8_BAR; PG8_SCHED;
            PG8_STG1(PG8_SB(1, 1), b3 + hstep, voffB0);
            PG8_WAIT_V(5); PG8_BAR; PG8_MMA(1, 1, At, B1); PG8_STG2(PG8_SB(1, 1), b3 + hstep, voffB1); PG8_BAR;
        }
        if constexpr (FP8) asm volatile("s_nop 15\n\ts_nop 15\n\ts_nop 15\n\ts_nop 15" ::: "memory");
        if (!DBG_K2 || (ui & 1)) E(acc, cur, wr, wc, fr, fq);
        if constexpr (DBG_EPI2 != 0 && Epi::IDEM) {
#pragma unroll
            for (int a = 0; a < 2; ++a)
#pragma unroll
                for (int b = 0; b < 2; ++b)
#pragma unroll
                    for (int m = 0; m < 4; ++m)
#pragma unroll
                        for (int n = 0; n < 2; ++n) asm volatile("" : "+v"(acc[a][b][m][n]));
            E(acc, cur, wr, wc, fr, fq); }
        if (!has_next) break;
        cur = nxt; cA = nA; cB = nB; ++ui;
    }
    PG8_WAIT_V(0);
    if (wr == 0) PG8_BAR;
    PG8_BAR;
#undef PG8_SA
#undef PG8_SB
#undef PG8_STAGE
#undef PG8_STAGE_A
#undef PG8_STG1
#undef PG8_STG2
#undef PG8_STGA1
#undef PG8_STGA2
#undef PG8_LDA
#undef PG8_LDB
#undef PG8_LD8
#undef PG8_HALF
#undef PG8_MMA
#undef PG8_ZERO
#undef PG8_WAIT_V
#undef PG8_WAIT_L
#undef PG8_BAR
#undef PG8_SCHED
#undef PG8_AOFF
}
}
using pg8::Unit; using pg8::Gemm; using pg8::DenseOrder;
typedef const f32x4 (&AccRef)[2][2][4][2];

__device__ __forceinline__ void st_bf16x8(bf16_t* p, f32x4 v0, f32x4 v1) {
    u32x4 w; w.x = cvt_pk_bf16(v0[0], v0[1]); w.y = cvt_pk_bf16(v0[2], v0[3]); w.z = cvt_pk_bf16(v1[0], v1[1]); w.w = cvt_pk_bf16(v1[2], v1[3]); *(u32x4*)p = w; }

constexpr float WU_SCALE = 16.0f;
constexpr float OUT_SCALE = 8.0f;
constexpr float WO_SCALE = 64.0f, ATT_SCALE = 32.0f;
constexpr float WIN_SCALE = 32.0f;
static_assert(WIN_SCALE == 32.0f, "gelu4_a32 / sigmoid4_a32 / the gate-up epilogue fold this scale into their constants");
struct EpiIn {
    static constexpr bool IDEM = true;
    bf16_t* Z; float* MID; bf16_t* GT; const float* bmerge;
    __device__ __forceinline__ void operator()(AccRef acc, const Unit& u, int wr, int wc, int fr, int fq) const {
        const int row0 = u.pm * 256 + wr * 64 + fr, cb = wc * 32 + 8 * fq;
        if (u.pn < 8) {
#pragma unroll
            for (int ai = 0; ai < 2; ++ai)
#pragma unroll
                for (int m = 0; m < 4; ++m) { unsigned char* rp = (unsigned char*)Z + (size_t)(row0 + ai * 128 + m * 16) * 2048 + u.pn * 256 + cb;
#pragma unroll
                    for (int bj = 0; bj < 2; ++bj) { const f32x4 v0 = gelu4_a32(acc[ai][bj][m][0]), v1 = gelu4_a32(acc[ai][bj][m][1]);
                        u32x2 w; w.x = cvt_pk4_fp8(v0[0], v0[1], v0[2], v0[3]); w.y = cvt_pk4_fp8(v1[0], v1[1], v1[2], v1[3]); *(u32x2*)(rp + bj * 128) = w; } }
        } else if (u.pn < 11) {
#pragma unroll
            for (int ai = 0; ai < 2; ++ai)
#pragma unroll
                for (int m = 0; m < 4; ++m) { bf16_t* rp = (bf16_t*)MID + (size_t)(row0 + ai * 128 + m * 16) * NMID + (u.pn - 8) * 256 + cb;
#pragma unroll
                    for (int bj = 0; bj < 2; ++bj) st_bf16x8(rp + bj * 128, acc[ai][bj][m][0] * (1.0f / WIN_SCALE), acc[ai][bj][m][1] * (1.0f / WIN_SCALE)); }
        } else if (DBG_STOP != 24) {
            const int c0 = (u.pn - 11) * 256 + cb;
            f32x4 bv[2][2];
#pragma unroll
            for (int bj = 0; bj < 2; ++bj) { bv[bj][0] = *(const f32x4*)(bmerge + c0 + bj * 128) * (-1.4426950408889634f); bv[bj][1] = *(const f32x4*)(bmerge + c0 + bj * 128 + 4) * (-1.4426950408889634f); }
#pragma unroll
            for (int ai = 0; ai < 2; ++ai)
#pragma unroll
                for (int m = 0; m < 4; ++m) { unsigned char* rp = (unsigned char*)GT + (size_t)(row0 + ai * 128 + m * 16) * 2048 + c0;
#pragma unroll
                    for (int bj = 0; bj < 2; ++bj) { const f32x4 v0 = sigmoid4_a32(acc[ai][bj][m][0], bv[bj][0]), v1 = sigmoid4_a32(acc[ai][bj][m][1], bv[bj][1]);
                        u32x2 w; w.x = cvt_pk4_fp8(v0[0], v0[1], v0[2], v0[3]); w.y = cvt_pk4_fp8(v1[0], v1[1], v1[2], v1[3]); *(u32x2*)(rp + bj * 128) = w; } }
        }
    }
};
struct EpiQ {
    static constexpr bool IDEM = true;
    bf16_t* Q; const float* rcos; const float* rsin; float sc;
    __device__ __forceinline__ void operator()(AccRef acc, const Unit& u, int wr, int wc, int fr, int fq) const {
        const int row0 = u.pm * 256 + wr * 64 + fr, cb = u.pn * 256 + wc * 32 + 8 * fq;
        const int bl = u.pm / 9; const bool lat = (u.pm - bl * 9) != 0;
        const int hc0 = cb % 192, hc1 = (cb + 128) % 192; const bool rot0 = lat && hc0 >= 128, rot1 = lat && hc1 >= 128;
        const int i00 = rot0 ? (hc0 - 128) >> 1 : 0, i01 = rot1 ? (hc1 - 128) >> 1 : 0;
#pragma unroll
        for (int ai = 0; ai < 2; ++ai) {
            f32x4 cs[4][2], sn[4][2];
#pragma unroll
            for (int m = 0; m < 4; ++m) { const int row = row0 + ai * 128 + m * 16; const int pos = row - bl * RPB - CTX;
                if (rot0) { cs[m][0] = *(const f32x4*)(rcos + pos * 32 + i00); sn[m][0] = *(const f32x4*)(rsin + pos * 32 + i00); }
                if (rot1) { cs[m][1] = *(const f32x4*)(rcos + pos * 32 + i01); sn[m][1] = *(const f32x4*)(rsin + pos * 32 + i01); } }
            asm volatile("" ::: "memory");
#pragma unroll
            for (int m = 0; m < 4; ++m) { const int row = row0 + ai * 128 + m * 16; unsigned char* rp = (unsigned char*)Q + (size_t)row * 1536 + cb;
#pragma unroll
                for (int bj = 0; bj < 2; ++bj) { f32x4 v0 = acc[ai][bj][m][0] * sc, v1 = acc[ai][bj][m][1] * sc;
                    if (bj == 0 ? rot0 : rot1) { const f32x4 o1 = v0 * cs[m][bj] - v1 * sn[m][bj], o2 = v0 * sn[m][bj] + v1 * cs[m][bj]; v0 = o1; v1 = o2; }
                    u32x2 w; w.x = cvt_pk4_fp8(v0[0], v0[1], v0[2], v0[3]); w.y = cvt_pk4_fp8(v1[0], v1[1], v1[2], v1[3]); *(u32x2*)(rp + bj * 128) = w; } }
            asm volatile("" ::: "memory");
        }
    }
};
struct EpiStore {
    static constexpr bool IDEM = true;
    unsigned char* VT; int ldc; float sc; unsigned char* KN;
    __device__ __forceinline__ void operator()(AccRef acc, const Unit& u, int wr, int wc, int fr, int fq) const {
        const int row0 = u.pm * 256 + wr * 64 + fr, cb = u.pn * 256 + wc * 32 + 8 * fq;
#pragma unroll
        for (int ai = 0; ai < 2; ++ai)
#pragma unroll
            for (int m = 0; m < 4; ++m) { const size_t row = (size_t)(row0 + ai * 128 + m * 16);
                { const f32x4 v0 = acc[ai][0][m][0] * sc, v1 = acc[ai][0][m][1] * sc; u32x2 w; w.x = cvt_pk4_fp8(v0[0], v0[1], v0[2], v0[3]); w.y = cvt_pk4_fp8(v1[0], v1[1], v1[2], v1[3]);
                  *(u32x2*)(KN + row * 1024 + u.pn * 128 + wc * 32 + 8 * fq) = w; }
                { const f32x4 v0 = acc[ai][1][m][0] * sc, v1 = acc[ai][1][m][1] * sc; const unsigned w0 = cvt_pk4_fp8(v0[0], v0[1], v0[2], v0[3]), w1 = cvt_pk4_fp8(v1[0], v1[1], v1[2], v1[3]);
                  const int key = (int)(row & 63), slot = ((key >> 2) & 1) * 32 + (key >> 5) * 16 + ((key >> 3) & 3) * 4 + (key & 3);
                  unsigned char* vp = VT + (((row >> 6) * 8 + u.pn) * 128 + wc * 32 + 8 * fq) * 64 + slot;
#pragma unroll
                  for (int j = 0; j < 4; ++j) { vp[j * 64] = (unsigned char)(w0 >> (8 * j)); vp[(j + 4) * 64] = (unsigned char)(w1 >> (8 * j)); } } }
    }
};
template <bool ADD> struct EpiProj {
    static constexpr bool IDEM = true;
    bf16_t* Y; const bf16_t* GT; int goff; unsigned char* Y8; float sc;
    __device__ __forceinline__ void operator()(AccRef acc, const Unit& u, int wr, int wc, int fr, int fq) const {
        const int row0 = u.pm * 256 + wr * 64 + fr, cb = u.pn * 256 + wc * 32 + 8 * fq;
#pragma unroll
        for (int ai = 0; ai < 2; ++ai) {
            u32x2 gw[4][2]; u32x4 yw[4][2];
#pragma unroll
            for (int m = 0; m < 4; ++m) { const size_t row = (size_t)(row0 + ai * 128 + m * 16);
#pragma unroll
                for (int bj = 0; bj < 2; ++bj) { const int c = cb + bj * 128;
                    gw[m][bj] = *(const u32x2*)((const unsigned char*)GT + row * 2048 + goff + c);
                    if (ADD) yw[m][bj] = *(const u32x4*)(Y + row * 1024 + c); } }
            asm volatile("" ::: "memory");
#pragma unroll
            for (int m = 0; m < 4; ++m) { const size_t row = (size_t)(row0 + ai * 128 + m * 16);
#pragma unroll
                for (int bj = 0; bj < 2; ++bj) { const int c = cb + bj * 128;
                    const f32x4 g0 = fp8x4_f32(gw[m][bj].x), g1 = fp8x4_f32(gw[m][bj].y);
                    f32x4 v0 = acc[ai][bj][m][0] * sc, v1 = acc[ai][bj][m][1] * sc;
                    if (ADD && DBG_NOATT) { v0 = v0 * 0.f; v1 = v1 * 0.f; }
                    if (!ADD && DBG_NOGMB) { v0 = v0 * 0.f; v1 = v1 * 0.f; }
                    if (ADD || !DBG_GA1) { v0 = v0 * g0; v1 = v1 * g1; }
                    if (ADD) { const u32x4 y4 = yw[m][bj];
                        v0[0] += bf_lo(y4.x); v0[1] += bf_hi(y4.x); v0[2] += bf_lo(y4.y); v0[3] += bf_hi(y4.y);
                        v1[0] += bf_lo(y4.z); v1[1] += bf_hi(y4.z); v1[2] += bf_lo(y4.w); v1[3] += bf_hi(y4.w);
                        u32x2 w; w.x = cvt_pk4_fp8(v0[0], v0[1], v0[2], v0[3]); w.y = cvt_pk4_fp8(v1[0], v1[1], v1[2], v1[3]); *(u32x2*)(Y8 + row * 1024 + c) = w; }
                    else st_bf16x8(Y + row * 1024 + c, v0, v1); } }
            asm volatile("" ::: "memory");
        }
    }
};
struct EpiOut {
    static constexpr bool IDEM = false;
    bf16_t* LAT; const float* x; const float* ctx; const float* mod; int g, first;
    __device__ __forceinline__ void operator()(AccRef acc, const Unit& u, int wr, int wc, int fr, int fq) const {
        const int row0 = u.pm * 256 + wr * 64 + fr, cb = u.pn * 256 + wc * 32 + 8 * fq;
        const int bl = u.pm / 9, isctx = (u.pm - bl * 9) == 0, gb = g * GB + bl;
        const float* g1 = mod + (size_t)(isctx ? 32 : gb) * 6144 + 2048 + cb;
        f32x4 gv[2][2];
#pragma unroll
        for (int bj = 0; bj < 2; ++bj) { gv[bj][0] = *(const f32x4*)(g1 + bj * 128) * (1.0f / WO_SCALE); gv[bj][1] = *(const f32x4*)(g1 + bj * 128 + 4) * (1.0f / WO_SCALE); }
        if (first) body<true>(acc, row0, cb, bl, isctx, gb, gv); else body<false>(acc, row0, cb, bl, isctx, gb, gv);
    }
    template <bool FIRST> __device__ __forceinline__ void body(AccRef acc, int row0, int cb, int bl, int isctx, int gb, const f32x4 (&gv)[2][2]) const {
#pragma unroll
        for (int ai = 0; ai < 2; ++ai)
#pragma unroll
            for (int mp = 0; mp < 2; ++mp) {
                f32x4 r0[2][2], r1[2][2];
#pragma unroll
                for (int mm = 0; mm < 2; ++mm) { const int row = row0 + ai * 128 + (mp * 2 + mm) * 16; const int rr = row - bl * RPB;
                    const float* res = isctx ? ctx + ((size_t)gb * CTX + rr) * 1024 : x + ((size_t)gb * SEQ + (rr - CTX)) * 1024;
                    const bf16_t* op = LAT + (size_t)row * 1024;
#pragma unroll
                    for (int bj = 0; bj < 2; ++bj) { const int c = cb + bj * 128;
                        if (FIRST) { r0[mm][bj] = *(const f32x4*)(res + c); r1[mm][bj] = *(const f32x4*)(res + c + 4); }
                        else { const u32x4 w = *(const u32x4*)(op + c); r0[mm][bj] = (f32x4){bf_lo(w.x), bf_hi(w.x), bf_lo(w.y), bf_hi(w.y)}; r1[mm][bj] = (f32x4){bf_lo(w.z), bf_hi(w.z), bf_lo(w.w), bf_hi(w.w)}; } } }
                asm volatile("" ::: "memory");
#pragma unroll
                for (int mm = 0; mm < 2; ++mm) { const int m = mp * 2 + mm; bf16_t* op = LAT + (size_t)(row0 + ai * 128 + m * 16) * 1024;
#pragma unroll
                    for (int bj = 0; bj < 2; ++bj) st_bf16x8(op + cb + bj * 128, ALPHA * r0[mm][bj] + gv[bj][0] * acc[ai][bj][m][0], ALPHA * r1[mm][bj] + gv[bj][1] * acc[ai][bj][m][1]); }
                asm volatile("" ::: "memory");
            }
    }
};
struct MoeOrder {
    static constexpr bool GATHER = false;
    const volatile LAS int* pre;
    int G, c;
    __device__ __forceinline__ bool next(int i, Unit& u) const {
        int tix, pn4;
        if ((G & 31) == 0) { const int x = c & 7, k = c >> 3; tix = i * (G >> 2) + x * (G >> 5) + (k >> 2); pn4 = k & 3; }
        else { const int L = i * G + c; tix = L >> 2; pn4 = L & 3; }
        int ln; asm volatile("v_mbcnt_lo_u32_b32 %0, -1, 0\n\tv_mbcnt_hi_u32_b32 %0, -1, %0" : "=v"(ln));
        const int pl = pre[ln < 17 ? ln : 16];
        const int ntile = __builtin_amdgcn_readlane(pl, 16); if (tix >= ntile) return false;
        const int e = __popcll(__ballot(ln >= 1 && ln < 16 && tix >= pl));
        u.pm = tix - __builtin_amdgcn_readlane(pl, e); u.pn = pn4; u.bt = e * 4 + u.pn; u.aux = e; return true;
    }
    __device__ __forceinline__ unsigned arow(const Unit& u, int r) const { return (unsigned)(__builtin_amdgcn_readfirstlane(pre[33 + u.aux]) + u.pm * 256 + r); }
};
struct EpiGU {
    static constexpr bool IDEM = true;
    bf16_t* ACT; const volatile LAS int* pre;
    __device__ __forceinline__ void operator()(AccRef acc, const Unit& u, int wr, int wc, int fr, int fq) const {
        const int n = pre[17 + u.aux], eb = pre[33 + u.aux]; const int cb = (u.pn * 256 + wc * 32 + 8 * fq) >> 1;
#pragma unroll
        for (int ai = 0; ai < 2; ++ai)
#pragma unroll
            for (int m = 0; m < 4; ++m) { const int idx = u.pm * 256 + ai * 128 + wr * 64 + m * 16 + fr;
                if (idx < n) { unsigned char* rp = (unsigned char*)ACT + (size_t)(eb + idx) * DE + cb;
#pragma unroll
                    for (int bj = 0; bj < 2; ++bj) { const f32x4 ag = acc[ai][bj][m][0], au = acc[ai][bj][m][1]; const f32x4 arg = ag * (-0.0450842200f); f32x4 r;
#pragma unroll
                        for (int j = 0; j < 4; ++j) r[j] = __builtin_amdgcn_rcpf(__builtin_amdgcn_exp2f(arg[j]) * 1024.0f + 1024.0f);
                        const f32x4 o = ag * au * r;
                        *(unsigned*)(rp + bj * 64) = cvt_pk4_fp8(o[0], o[1], o[2], o[3]); } } }
    }
};
struct EpiDown {
    static constexpr bool IDEM = true;
    bf16_t* OUT; const volatile LAS int* pre;
    __device__ __forceinline__ void operator()(AccRef acc, const Unit& u, int wr, int wc, int fr, int fq) const {
        const int n = pre[17 + u.aux], eb = pre[33 + u.aux]; const int cb = u.pn * 256 + wc * 32 + 8 * fq;
#pragma unroll
        for (int ai = 0; ai < 2; ++ai)
#pragma unroll
            for (int m = 0; m < 4; ++m) { const int idx = u.pm * 256 + ai * 128 + wr * 64 + m * 16 + fr;
                if (idx < n) { unsigned char* rp = (unsigned char*)OUT + (size_t)(eb + idx) * 1024 + cb;
#pragma unroll
                    for (int bj = 0; bj < 2; ++bj) { const f32x4 v0 = acc[ai][bj][m][0] * (OUT_SCALE / WIN_SCALE), v1 = acc[ai][bj][m][1] * (OUT_SCALE / WIN_SCALE);
                        u32x2 w; w.x = cvt_pk4_fp8(v0[0], v0[1], v0[2], v0[3]); w.y = cvt_pk4_fp8(v1[0], v1[1], v1[2], v1[3]); *(u32x2*)(rp + bj * 128) = w; } } }
    }
};

namespace att {
constexpr int KVBLK = 64;
constexpr int SHM_V = KVBLK * 128, SHM_K = KVBLK * 256;
constexpr int K_OFF = 0, V_OFF = 3 * SHM_K, WSC_OFF = V_OFF + 3 * SHM_V, SHM_ATTN = WSC_OFF + 8 * 64 * 4;
constexpr float SCALE = 0.07216878364870322f;
constexpr float THR = 5.f;
#define SBAR() __builtin_amdgcn_sched_barrier(0)
typedef int i32x8a __attribute__((ext_vector_type(8)));
__device__ __forceinline__ int crow(int r, int hi) { return (r & 3) + 8 * (r >> 2) + 4 * hi; }
__device__ __forceinline__ void partialSM(f32x16& p0, f32x16& p1, float& m_reg, float& mn, float& alpha) {
  constexpr float C = SCALE * 1.4426950408889634f;
  float pmax = p0[0];
#pragma unroll
  for (int r = 1; r < 16; ++r) pmax = fmaxf(pmax, p0[r]);
#pragma unroll
  for (int r = 0; r < 16; ++r) pmax = fmaxf(pmax, p1[r]);
  { auto rr = __builtin_amdgcn_permlane32_swap(__float_as_uint(pmax), __float_as_uint(pmax), false, false);
    pmax = fmaxf(__uint_as_float(rr[0]), __uint_as_float(rr[1])); }
  if (__builtin_expect(__all(pmax - m_reg <= THR / SCALE), 1)) { mn = m_reg; alpha = 1.f; }
  else { mn = fmaxf(m_reg, pmax); alpha = __builtin_amdgcn_exp2f((m_reg - mn) * C); m_reg = mn; }
  float mnC = -mn * C;
#pragma unroll
  for (int r = 0; r < 16; ++r) p0[r] = fmaf(p0[r], C, mnC);
#pragma unroll
  for (int r = 0; r < 16; ++r) p1[r] = fmaf(p1[r], C, mnC);
#pragma unroll
  for (int r = 0; r < 16; ++r) p0[r] = __builtin_amdgcn_exp2f(p0[r]);
}
__device__ __forceinline__ void finishSM(f32x16& p0, f32x16& p1, float alpha, float& l_reg, bf16x8& pa0, bf16x8& pa1, bf16x8& pa2, bf16x8& pa3) {
#pragma unroll
  for (int r = 0; r < 16; ++r) p1[r] = __builtin_amdgcn_exp2f(p1[r]);
  float ps = 0;
#pragma unroll
  for (int r = 0; r < 16; ++r) ps += p0[r];
#pragma unroll
  for (int r = 0; r < 16; ++r) ps += p1[r];
  { auto rr = __builtin_amdgcn_permlane32_swap(__float_as_uint(ps), __float_as_uint(ps), false, false);
    ps = __uint_as_float(rr[0]) + __uint_as_float(rr[1]); }
  l_reg = l_reg * alpha + ps;
#define PK4(P, BASE, OUT) do { unsigned a0 = cvt_pk_bf16(P[BASE + 0], P[BASE + 1]), a1 = cvt_pk_bf16(P[BASE + 2], P[BASE + 3]);   \
    unsigned b0 = cvt_pk_bf16(P[BASE + 4], P[BASE + 5]), b1 = cvt_pk_bf16(P[BASE + 6], P[BASE + 7]);                              \
    auto r0 = __builtin_amdgcn_permlane32_swap(a0, b0, false, false); auto r1 = __builtin_amdgcn_permlane32_swap(a1, b1, false, false); \
    u32x4 w = {r0[0], r1[0], r0[1], r1[1]}; OUT = *reinterpret_cast<bf16x8*>(&w); } while (0)
  PK4(p0, 0, pa0); PK4(p0, 8, pa1); PK4(p1, 0, pa2); PK4(p1, 8, pa3);
#undef PK4
}
__device__ __forceinline__ void qkt(f32x16& p0, f32x16& p1, const LAS char* Ks, const i32x8a* qf, int ka0, int ka1, int ka2) {
  p0 = f32x16{}; p1 = f32x16{};
#pragma unroll
  for (int s = 0; s < 3; ++s) { const int ka = s == 0 ? ka0 : s == 1 ? ka1 : ka2;
    const u32x4 l0 = *reinterpret_cast<const LAS u32x4*>(Ks + ka), h0 = *reinterpret_cast<const LAS u32x4*>(Ks + (ka ^ 16));
    const u32x4 l1 = *reinterpret_cast<const LAS u32x4*>(Ks + ka + 32 * 256), h1 = *reinterpret_cast<const LAS u32x4*>(Ks + (ka ^ 16) + 32 * 256);
    const i32x8a a0 = {(int)l0.x, (int)l0.y, (int)l0.z, (int)l0.w, (int)h0.x, (int)h0.y, (int)h0.z, (int)h0.w};
    const i32x8a a1 = {(int)l1.x, (int)l1.y, (int)l1.z, (int)l1.w, (int)h1.x, (int)h1.y, (int)h1.z, (int)h1.w};
    p0 = __builtin_amdgcn_mfma_scale_f32_32x32x64_f8f6f4(a0, qf[s], p0, 0, 0, 0, 0x7f7f7f7f, 0, 0x7f7f7f7f);
    p1 = __builtin_amdgcn_mfma_scale_f32_32x32x64_f8f6f4(a1, qf[s], p1, 0, 0, 0, 0x7f7f7f7f, 0, 0x7f7f7f7f); }
}
__device__ __forceinline__ void finishSM8(f32x16& p0, f32x16& p1, i32x8a& p8) {
#pragma unroll
  for (int r = 0; r < 16; ++r) p1[r] = __builtin_amdgcn_exp2f(p1[r]);
  p8 = (i32x8a){(int)cvt_pk4_fp8(p0[0], p0[1], p0[2], p0[3]), (int)cvt_pk4_fp8(p0[4], p0[5], p0[6], p0[7]), (int)cvt_pk4_fp8(p0[8], p0[9], p0[10], p0[11]), (int)cvt_pk4_fp8(p0[12], p0[13], p0[14], p0[15]),
                (int)cvt_pk4_fp8(p1[0], p1[1], p1[2], p1[3]), (int)cvt_pk4_fp8(p1[4], p1[5], p1[6], p1[7]), (int)cvt_pk4_fp8(p1[8], p1[9], p1[10], p1[11]), (int)cvt_pk4_fp8(p1[12], p1[13], p1[14], p1[15])};
}
#define LD8A(dst, base, off) do { const u32x4 l_ = *reinterpret_cast<const LAS u32x4*>((base) + (off)), h_ = *reinterpret_cast<const LAS u32x4*>((base) + ((off) ^ 16)); \
    dst = (i32x8a){(int)l_.x, (int)l_.y, (int)l_.z, (int)l_.w, (int)h_.x, (int)h_.y, (int)h_.z, (int)h_.w}; } while (0)
template <bool PV> __device__ __forceinline__ void mseg(f32x16& p0, f32x16& p1, const LAS char* Ks, const i32x8a* qf, int ka0, int ka1, int ka2, f32x16* o, const LAS char* Vs, int vx, i32x8a p8) {
  i32x8a k0[3], k1[3], vf[4];
  LD8A(k0[0], Ks, ka0); LD8A(k1[0], Ks + 32 * 256, ka0); LD8A(k0[1], Ks, ka1); LD8A(k1[1], Ks + 32 * 256, ka1); LD8A(k0[2], Ks, ka2); LD8A(k1[2], Ks + 32 * 256, ka2);
  SBAR();
  p0 = __builtin_amdgcn_mfma_scale_f32_32x32x64_f8f6f4(k0[0], qf[0], f32x16{}, 0, 0, 0, 0x7f7f7f7f, 0, 0x7f7f7f7f);
  p1 = __builtin_amdgcn_mfma_scale_f32_32x32x64_f8f6f4(k1[0], qf[0], f32x16{}, 0, 0, 0, 0x7f7f7f7f, 0, 0x7f7f7f7f);
  if (PV) { LD8A(vf[0], Vs, vx); LD8A(vf[1], Vs + 2048, vx); }
  SBAR();
  p0 = __builtin_amdgcn_mfma_scale_f32_32x32x64_f8f6f4(k0[1], qf[1], p0, 0, 0, 0, 0x7f7f7f7f, 0, 0x7f7f7f7f);
  p1 = __builtin_amdgcn_mfma_scale_f32_32x32x64_f8f6f4(k1[1], qf[1], p1, 0, 0, 0, 0x7f7f7f7f, 0, 0x7f7f7f7f);
  if (PV) { LD8A(vf[2], Vs + 4096, vx); LD8A(vf[3], Vs + 6144, vx); }
  SBAR();
  p0 = __builtin_amdgcn_mfma_scale_f32_32x32x64_f8f6f4(k0[2], qf[2], p0, 0, 0, 0, 0x7f7f7f7f, 0, 0x7f7f7f7f);
  p1 = __builtin_amdgcn_mfma_scale_f32_32x32x64_f8f6f4(k1[2], qf[2], p1, 0, 0, 0, 0x7f7f7f7f, 0, 0x7f7f7f7f);
  if (PV) {
    SBAR();
    { int one8 = 0x38383838; asm volatile("" : "+v"(one8)); const i32x8a ones = {one8, one8, one8, one8, one8, one8, one8, one8};
      o[4] = __builtin_amdgcn_mfma_scale_f32_32x32x64_f8f6f4(p8, ones, o[4], 0, 0, 0, 0x7f7f7f7f, 0, 0x7f7f7f7f); }
#pragma unroll
    for (int d0 = 0; d0 < 4; ++d0) o[d0] = __builtin_amdgcn_mfma_scale_f32_32x32x64_f8f6f4(p8, vf[d0], o[d0], 0, 0, 0, 0x7f7f7f7f, 0, 0x7f7f7f7f);
  }
}
__device__ __forceinline__ void pv8(f32x16* o, const LAS char* Vs, int vx, i32x8a p8) {
  { int one8 = 0x38383838; asm volatile("" : "+v"(one8)); const i32x8a ones = {one8, one8, one8, one8, one8, one8, one8, one8};
    o[4] = __builtin_amdgcn_mfma_scale_f32_32x32x64_f8f6f4(p8, ones, o[4], 0, 0, 0, 0x7f7f7f7f, 0, 0x7f7f7f7f); }
#pragma unroll
  for (int d0 = 0; d0 < 4; ++d0) {
    const u32x4 l = *reinterpret_cast<const LAS u32x4*>(Vs + d0 * 2048 + vx), h = *reinterpret_cast<const LAS u32x4*>(Vs + d0 * 2048 + (vx ^ 16));
    const i32x8a b = {(int)l.x, (int)l.y, (int)l.z, (int)l.w, (int)h.x, (int)h.y, (int)h.z, (int)h.w};
    o[d0] = __builtin_amdgcn_mfma_scale_f32_32x32x64_f8f6f4(p8, b, o[d0], 0, 0, 0, 0x7f7f7f7f, 0, 0x7f7f7f7f); }
}
__device__ __forceinline__ int v_st(int k, int c) { const int kk = (k & ~0xC) | ((k & 4) << 1) | ((k & 8) >> 1); return ((kk >> 3) * 4 + (c >> 5)) * 512 + ((kk & 7) * 32 + (c & 31)) * 2; }
__device__ __forceinline__ int v_rd_base(int lane) { return ((lane & 3) << 3) | (((lane >> 2) & 3) << 6) | (((lane >> 4) & 1) << 5) | (((lane >> 5) & 1) << 8); }
constexpr int v_rd_off(int d0, int ks, int half) { return d0 * 512 + ks * 4096 + half * 2048; }
template <int OFF> __device__ __forceinline__ s16x4 tr_read(int vb) {
  s16x4 r; asm volatile("ds_read_b64_tr_b16 %0, %1 offset:%2" : "=&v"(r) : "v"(vb), "i"(OFF) : "memory"); return r;
}
template <int D0> __device__ __forceinline__ void pv_one(f32x16& od, int vb, bf16x8 pa0, bf16x8 pa1, bf16x8 pa2, bf16x8 pa3) {
  const s16x4 l0 = tr_read<v_rd_off(D0, 0, 0)>(vb), h0 = tr_read<v_rd_off(D0, 0, 1)>(vb), l1 = tr_read<v_rd_off(D0, 1, 0)>(vb), h1 = tr_read<v_rd_off(D0, 1, 1)>(vb);
  const s16x4 l2 = tr_read<v_rd_off(D0, 2, 0)>(vb), h2 = tr_read<v_rd_off(D0, 2, 1)>(vb), l3 = tr_read<v_rd_off(D0, 3, 0)>(vb), h3 = tr_read<v_rd_off(D0, 3, 1)>(vb);
  asm volatile("s_waitcnt lgkmcnt(0)" ::: "memory"); SBAR();
#define PK(L, H) (bf16x8){L[0], L[1], L[2], L[3], H[0], H[1], H[2], H[3]}
  od = __builtin_amdgcn_mfma_f32_32x32x16_bf16(pa0, PK(l0, h0), od, 0, 0, 0);
  od = __builtin_amdgcn_mfma_f32_32x32x16_bf16(pa1, PK(l1, h1), od, 0, 0, 0);
  od = __builtin_amdgcn_mfma_f32_32x32x16_bf16(pa2, PK(l2, h2), od, 0, 0, 0);
  od = __builtin_amdgcn_mfma_f32_32x32x16_bf16(pa3, PK(l3, h3), od, 0, 0, 0);
#undef PK
}
template <int D0> __device__ __forceinline__ void pv_one_t(f32x16& od, int vb, bf16x8 pa0, bf16x8 pa1, bf16x8 pa2, bf16x8 pa3) {
  const s16x4 l0 = tr_read<v_rd_off(D0, 0, 0)>(vb), h0 = tr_read<v_rd_off(D0, 0, 1)>(vb), l1 = tr_read<v_rd_off(D0, 1, 0)>(vb), h1 = tr_read<v_rd_off(D0, 1, 1)>(vb);
  const s16x4 l2 = tr_read<v_rd_off(D0, 2, 0)>(vb), h2 = tr_read<v_rd_off(D0, 2, 1)>(vb), l3 = tr_read<v_rd_off(D0, 3, 0)>(vb), h3 = tr_read<v_rd_off(D0, 3, 1)>(vb);
  asm volatile("s_waitcnt lgkmcnt(0)" ::: "memory"); SBAR();
#define PK(L, H) (bf16x8){L[0], L[1], L[2], L[3], H[0], H[1], H[2], H[3]}
  od = __builtin_amdgcn_mfma_f32_32x32x16_bf16(PK(l0, h0), pa0, od, 0, 0, 0);
  od = __builtin_amdgcn_mfma_f32_32x32x16_bf16(PK(l1, h1), pa1, od, 0, 0, 0);
  od = __builtin_amdgcn_mfma_f32_32x32x16_bf16(PK(l2, h2), pa2, od, 0, 0, 0);
  od = __builtin_amdgcn_mfma_f32_32x32x16_bf16(PK(l3, h3), pa3, od, 0, 0, 0);
#undef PK
}
__device__ __forceinline__ void pv_d0(f32x16* o, int vb, bf16x8 pa0, bf16x8 pa1, bf16x8 pa2, bf16x8 pa3) {
  pv_one<0>(o[0], vb, pa0, pa1, pa2, pa3); pv_one<1>(o[1], vb, pa0, pa1, pa2, pa3); pv_one<2>(o[2], vb, pa0, pa1, pa2, pa3); pv_one<3>(o[3], vb, pa0, pa1, pa2, pa3);
}
__device__ __forceinline__ void attn_body(const unsigned char* __restrict__ Qb, const unsigned char* __restrict__ wsb, unsigned vto, unsigned kno, unsigned kro, bf16_t* __restrict__ Ob, int ntile, LAS char* lds, int tid) {
  const int wid = __builtin_amdgcn_readfirstlane(tid >> 6), lane = tid & 63, r32 = lane & 31, hi = lane >> 5;
  LAS float* wsp = (LAS float*)(lds + WSC_OFF) + wid * 64; LAS float* li_l = wsp; LAS float* al_l = wsp + 32;
  float m_reg = -1e30f; f32x16 o[5] = {}; i32x8a qr[3];
  const unsigned char* Qw = Qb + (size_t)(wid * 32 + r32) * 1536 + hi * 32;
#pragma unroll
  for (int s3 = 0; s3 < 3; ++s3) { const u32x4 ql = *reinterpret_cast<const u32x4*>(Qw + s3 * 64), qh = *reinterpret_cast<const u32x4*>(Qw + s3 * 64 + 16);
    qr[s3] = (i32x8a){(int)ql.x, (int)ql.y, (int)ql.z, (int)ql.w, (int)qh.x, (int)qh.y, (int)qh.z, (int)qh.w}; }
  unsigned ko0, ko1, ki0, ki1, vo0;
#define KSRC(i, KO, KI) do { const int p = (wid * 2 + (i)) * 64 + lane, row = p >> 4, c = (p & 15) ^ (row & 15); \
    if (c >= 8 && c < 12) { KO = kro + (unsigned)(row * 64 + (c - 8) * 16); KI = KVBLK * 64; } else { KO = kno + (unsigned)(row * 1024 + (c < 8 ? c : 0) * 16); KI = KVBLK * 1024; } } while (0)
  KSRC(0, ko0, ki0); KSRC(1, ko1, ki1);
#undef KSRC
  { const int p = wid * 64 + lane, d = p >> 2, c = (p & 3) ^ ((d >> 2) & 3); vo0 = vto + (unsigned)(d * 64 + c * 16); }
  const int kxb = r32 * 256, sw = r32 & 15;
  const int kx0 = kxb + 16 * ((0 + 2 * hi) ^ sw), kx1 = kxb + 16 * ((4 + 2 * hi) ^ sw), kx2 = kxb + 16 * ((8 + 2 * hi) ^ sw);
  const int vx = r32 * 64 + 16 * ((2 * hi) ^ ((r32 >> 2) & 3));
#define GLDS(src, dst) __builtin_amdgcn_global_load_lds((const unsigned*)(src), (LAS unsigned*)(dst), 16, 0, 0)
#define ISSUE_K(t, slot) do { const unsigned _t = (unsigned)(t); LAS char* _d = lds + K_OFF + (slot) * SHM_K + wid * 2048; \
    GLDS(wsb + (ko0 + _t * ki0), _d); GLDS(wsb + (ko1 + _t * ki1), _d + 1024); } while (0)
#define ISSUE_V(t, slot) do { const unsigned _t = (unsigned)(t) * 65536u; LAS char* _d = lds + V_OFF + (slot) * SHM_V + wid * 1024; GLDS(wsb + (vo0 + _t), _d); } while (0)
#define RESC(a) do { if (__any((a) < 1.f)) { if (hi == 0) al_l[r32] = (a); asm volatile("s_waitcnt lgkmcnt(0)" ::: "memory"); \
    _Pragma("unroll") for (int d = 0; d < 5; ++d) _Pragma("unroll") for (int r = 0; r < 16; ++r) o[d][r] *= al_l[crow(r, hi)]; } } while (0)
  f32x16 pS0, pS1; float mnS, alS; i32x8a p8 = {};
  const int tl = ntile - 1; const bool lagh = wid >= 4;
#define BARX() do { SBAR(); __builtin_amdgcn_s_barrier(); SBAR(); } while (0)
  ISSUE_K(0, 0); ISSUE_V(0, 0); ISSUE_K(1, 1);
  asm volatile("s_waitcnt vmcnt(0)" ::: "memory"); __builtin_amdgcn_s_barrier();
  if (lagh) BARX();
  { const int tk = 2 < tl ? 2 : tl, tv = 1 < tl ? 1 : tl; ISSUE_K(tk, 2); ISSUE_V(tv, 1); }
  mseg<false>(pS0, pS1, lds + K_OFF, qr, kx0, kx1, kx2, o, lds + V_OFF, vx, p8);
  asm volatile("s_waitcnt vmcnt(3)" ::: "memory"); BARX();
  partialSM(pS0, pS1, m_reg, mnS, alS); RESC(alS); finishSM8(pS0, pS1, p8);
  BARX();
  int sj = 1;
  for (int j = 1; j <= tl; ++j) {
    const int s1 = sj == 2 ? 0 : sj + 1, s2 = s1 == 2 ? 0 : s1 + 1;
    { const int tk = j + 2 < tl ? j + 2 : tl, tv = j + 1 < tl ? j + 1 : tl; ISSUE_K(tk, s2); ISSUE_V(tv, s1); }
    SBAR(); mseg<true>(pS0, pS1, lds + K_OFF + sj * SHM_K, qr, kx0, kx1, kx2, o, lds + V_OFF + s2 * SHM_V, vx, p8);
    asm volatile("s_waitcnt vmcnt(3)" ::: "memory"); BARX();
    partialSM(pS0, pS1, m_reg, mnS, alS); RESC(alS); finishSM8(pS0, pS1, p8);
    BARX();
    sj = s1;
  }
  { const int sl = sj == 0 ? 2 : sj - 1; pv8(o, lds + V_OFF + sl * SHM_V, vx, p8); }
  if (!lagh) BARX();
#undef BARX
  asm volatile("s_waitcnt vmcnt(0) lgkmcnt(0)" ::: "memory"); __builtin_amdgcn_s_barrier();
  float rli[16];
#pragma unroll
  for (int r = 0; r < 16; ++r) rli[r] = ATT_SCALE * __builtin_amdgcn_rcpf(o[4][r]);
  unsigned char* Ow = (unsigned char*)Ob + (size_t)(wid * 32) * 1024;
  const unsigned sel1 = (lane & 1) ? 0x03070105u : 0x06020400u, sel2 = (lane & 2) ? 0x03020706u : 0x05040100u;
  unsigned char* Oq = Ow + (size_t)(4 * hi + (lane & 3)) * 1024 + 4 * (r32 >> 2);
#pragma unroll
  for (int d0 = 0; d0 < 4; ++d0)
#pragma unroll
    for (int k = 0; k < 4; ++k) {
      unsigned x = cvt_pk4_fp8(o[d0][4 * k] * rli[4 * k], o[d0][4 * k + 1] * rli[4 * k + 1], o[d0][4 * k + 2] * rli[4 * k + 2], o[d0][4 * k + 3] * rli[4 * k + 3]);
      const unsigned t1 = (unsigned)__builtin_amdgcn_update_dpp(0, (int)x, 0xB1, 0xf, 0xf, false);
      x = __builtin_amdgcn_perm(t1, x, sel1);
      const unsigned t2 = (unsigned)__builtin_amdgcn_update_dpp(0, (int)x, 0x4E, 0xf, 0xf, false);
      x = __builtin_amdgcn_perm(t2, x, sel2);
      *(unsigned*)(Oq + (size_t)(8 * k) * 1024 + d0 * 32) = x; }
#undef GLDS
#undef ISSUE_K
#undef ISSUE_V
#undef RESC
#undef STEP
}
}

__global__ void __launch_bounds__(NT, 2) mk_fwd(Params P) {
    extern __shared__ __attribute__((aligned(16))) unsigned char lds_raw[];
    LAS unsigned char* lds = (LAS unsigned char*)lds_raw;
    constexpr int MISC_OFF = 131072;
    volatile LAS unsigned* MISC = (volatile LAS unsigned*)(lds + MISC_OFF);
    volatile LAS int* PRE = (volatile LAS int*)(MISC + 16);
    const int G = gridDim.x, bid = blockIdx.x;
    const int wid0 = __builtin_amdgcn_readfirstlane(threadIdx.x >> 6);
    if (threadIdx.x < 64) MISC[threadIdx.x] = 0u;
    __syncthreads();
    XcdBarrier bar = xcd_barrier_post((unsigned*)(P.ws + WS_CTL) + CW_BAR, MISC);
#define PHASE_IDS() int wid = wid0; asm volatile("" : "+s"(wid)); int tid; asm volatile("v_mbcnt_lo_u32_b32 %0, -1, 0\n\tv_mbcnt_hi_u32_b32 %0, -1, %0" : "=v"(tid)); tid += wid * 64; const int lane = tid & 63; (void)lane; (void)wid; \
    GAS unsigned char* wsg_ = (GAS unsigned char*)P.ws; asm volatile("" : "+s"(wsg_)); unsigned char* ws = (unsigned char*)wsg_
#define WSP(T, off) ((T*)(ws + (off)))

    if (PH(0)) {
        PHASE_IDS();
        float* MOD = WSP(float, WS_MOD);
        REPS(0) {
        LAS float* red = (LAS float*)lds;
        for (int u = bid; u < 2 * 96; u += G) {
            const int l = u / 96, c0 = (u % 96) * 64;
            const float* W = P.in[I_WADA] + (size_t)l * 1024 * 6144 + c0 + lane;
            LAS float* tab = red + wid * 33 * 64;
            float acc[33];
#pragma unroll
            for (int r = 0; r < 33; ++r) acc[r] = 0.f;
            for (int p = 0; p < 2; ++p) { const int kb = wid * 128 + p * 64;
#pragma unroll
                for (int r = 0; r < 33; ++r) { const float cv = (r < 32) ? P.in[I_C][r * 1024 + kb + lane] : P.in[I_CCTX][kb + lane]; tab[r * 64 + lane] = cv / (1.0f + __expf(-cv)); }
                asm volatile("s_waitcnt lgkmcnt(0)" ::: "memory");
                float wv[2][16];
#pragma unroll
                for (int kk = 0; kk < 16; ++kk) wv[0][kk] = W[(size_t)(kb + kk) * 6144];
#pragma unroll
                for (int bt = 0; bt < 4; ++bt) {
                    if (bt < 3) {
#pragma unroll
                        for (int kk = 0; kk < 16; ++kk) wv[(bt + 1) & 1][kk] = W[(size_t)(kb + (bt + 1) * 16 + kk) * 6144]; }
#pragma unroll
                    for (int kq = 0; kq < 4; ++kq) {
                        const float w0 = wv[bt & 1][4 * kq], w1 = wv[bt & 1][4 * kq + 1], w2 = wv[bt & 1][4 * kq + 2], w3 = wv[bt & 1][4 * kq + 3];
#pragma unroll
                        for (int r0 = 0; r0 < 33; r0 += 11) { f32x4 t4[11];
#pragma unroll
                            for (int rr = 0; rr < 11; ++rr) t4[rr] = *(const LAS f32x4*)(tab + (r0 + rr) * 64 + bt * 16 + kq * 4);
#pragma unroll
                            for (int rr = 0; rr < 11; ++rr) acc[r0 + rr] = fmaf(t4[rr][3], w3, fmaf(t4[rr][2], w2, fmaf(t4[rr][1], w1, fmaf(t4[rr][0], w0, acc[r0 + rr])))); }
                        asm volatile("" ::: "memory"); } }
                asm volatile("s_waitcnt lgkmcnt(0)" ::: "memory"); }
            __syncthreads();
#pragma unroll
            for (int r = 0; r < 33; ++r) red[(wid * 33 + r) * 64 + lane] = acc[r];
            __syncthreads();
            for (int o = tid; o < 33 * 64; o += NT) { const int r = o >> 6, cl = o & 63; float sm = 0.f;
#pragma unroll
                for (int w = 0; w < 8; ++w) sm += red[(w * 33 + r) * 64 + cl];
                MOD[((size_t)l * 33 + r) * 6144 + c0 + cl] = sm + P.in[I_BADA][l * 6144 + c0 + cl]; }
            __syncthreads();
        }
        { float* RCOS = WSP(float, WS_ROPE); float* RSIN = RCOS + 2048 * 32;
          for (int i = bid * NT + tid; i < 2048 * 32; i += G * NT) { const int pos = i >> 5, f = i & 31; const int rw = pos >> 6, cl = pos & 63;
            const float inv = powf(10000.0f, -(float)(f & 15) / 16.0f); const float ang = (float)(f < 16 ? rw : cl) * inv;
            RCOS[i] = cosf(ang); RSIN[i] = sinf(ang); } }
        LAS float* tile = (LAS float*)lds;
#define XP_LOAD(t_, V) do { const int n0_ = ((t_) / ntk) * 64, k0_ = ((t_) % ntk) * 128; const int nl = tid & 63, kl = tid >> 6; const float* cp = colptr(n0_ + nl); \
        _Pragma("unroll") for (int kk = 0; kk < 16; ++kk) V[kk] = (cp && k0_ + kl + 8 * kk < kmax) ? cp[(size_t)(k0_ + kl + 8 * kk) * ld] : 0.f; } while (0)
#define XP_BAR() do { asm volatile("s_waitcnt lgkmcnt(0)" ::: "memory"); __builtin_amdgcn_s_barrier(); } while (0)
        auto xpose = [&](bf16_t* dst, int N, int K, int ld, auto colptr, int rot) {
            const int ntk = K / 128, ntot = (N / 64) * ntk, kmax = K;
            float v[16], vn[16]; int t = (bid + rot) % G;
            if (t < ntot) XP_LOAD(t, v);
            for (; t < ntot; t += G) {
                const int n0 = (t / ntk) * 64, k0 = (t % ntk) * 128;
                { const int tn = t + G < ntot ? t + G : t; XP_LOAD(tn, vn); }
                { const int nl = tid & 63, kl = tid >> 6;
#pragma unroll
                  for (int kk = 0; kk < 16; ++kk) tile[(kl + 8 * kk) * 65 + nl] = v[kk]; }
                XP_BAR();
                { const int n = tid & 63, k16 = (tid >> 6) * 16; u32x4 w0, w1;
                  w0.x = cvt_pk_bf16(tile[(k16 + 0) * 65 + n], tile[(k16 + 1) * 65 + n]); w0.y = cvt_pk_bf16(tile[(k16 + 2) * 65 + n], tile[(k16 + 3) * 65 + n]);
                  w0.z = cvt_pk_bf16(tile[(k16 + 4) * 65 + n], tile[(k16 + 5) * 65 + n]); w0.w = cvt_pk_bf16(tile[(k16 + 6) * 65 + n], tile[(k16 + 7) * 65 + n]);
                  w1.x = cvt_pk_bf16(tile[(k16 + 8) * 65 + n], tile[(k16 + 9) * 65 + n]); w1.y = cvt_pk_bf16(tile[(k16 + 10) * 65 + n], tile[(k16 + 11) * 65 + n]);
                  w1.z = cvt_pk_bf16(tile[(k16 + 12) * 65 + n], tile[(k16 + 13) * 65 + n]); w1.w = cvt_pk_bf16(tile[(k16 + 14) * 65 + n], tile[(k16 + 15) * 65 + n]);
                  u32x4* dp = (u32x4*)(dst + (size_t)(n0 + n) * K + k0 + k16); dp[0] = w0; dp[1] = w1; }
                XP_BAR();
#pragma unroll
                for (int kk = 0; kk < 16; ++kk) v[kk] = vn[kk];
            }
        };
        auto xpose8 = [&](unsigned char* dst, int N, int K, int ld, auto colptr, float scale, int kmax) {
            const int ntk = K / 128, ntot = (N / 64) * ntk;
            float v[16], vn[16], vm[16]; int t = bid;
            if (t < ntot) { XP_LOAD(t, v); const int t1 = t + G < ntot ? t + G : t; XP_LOAD(t1, vn); }
            for (; t < ntot; t += G) {
                const int n0 = (t / ntk) * 64, k0 = (t % ntk) * 128;
                { const int tn = t + 2 * G < ntot ? t + 2 * G : t; XP_LOAD(tn, vm); }
                { const int nl = tid & 63, kl = tid >> 6;
#pragma unroll
                  for (int kk = 0; kk < 16; ++kk) tile[(kl + 8 * kk) * 65 + nl] = v[kk] * scale; }
                XP_BAR();
                { const int n = tid & 63, k16 = (tid >> 6) * 16; u32x4 w;
                  w.x = cvt_pk4_fp8(tile[(k16 + 0) * 65 + n], tile[(k16 + 1) * 65 + n], tile[(k16 + 2) * 65 + n], tile[(k16 + 3) * 65 + n]);
                  w.y = cvt_pk4_fp8(tile[(k16 + 4) * 65 + n], tile[(k16 + 5) * 65 + n], tile[(k16 + 6) * 65 + n], tile[(k16 + 7) * 65 + n]);
                  w.z = cvt_pk4_fp8(tile[(k16 + 8) * 65 + n], tile[(k16 + 9) * 65 + n], tile[(k16 + 10) * 65 + n], tile[(k16 + 11) * 65 + n]);
                  w.w = cvt_pk4_fp8(tile[(k16 + 12) * 65 + n], tile[(k16 + 13) * 65 + n], tile[(k16 + 14) * 65 + n], tile[(k16 + 15) * 65 + n]);
                  *(u32x4*)(dst + (size_t)(n0 + n) * K + k0 + k16) = w; }
                XP_BAR();
#pragma unroll
                for (int kk = 0; kk < 16; ++kk) { v[kk] = vn[kk]; vn[kk] = vm[kk]; }
            }
        };
        { const float* src = P.in[I_WIN];
          xpose8(WSP(unsigned char, WS_WIN), 2 * NIN, 1024, IN_COLS, [=](int n) -> const float* { const int l = n / NIN, q = n - l * NIN; int col;
              if (q < 2048) col = q; else if (q < 2304) col = OFF_KV + (q - 2048); else if (q < 2368) col = OFF_KR + rope_orig(q - 2304);
              else if (q < 2752) col = OFF_Q + (q - 2368); else if (q < 2816) return (const float*)nullptr; else col = OFF_G + (q - 2816);
              return src + (size_t)l * 1024 * IN_COLS + col; }, WIN_SCALE, 1024); }
        { const float* src = P.in[I_WUQ];
          xpose8(WSP(unsigned char, WS_WUQ), 2 * 1536, 512, 1536, [=](int n) -> const float* { const int l = n / 1536, q = n - l * 1536; const int hd = q / 192, hc = q - hd * 192;
              const int col = hd * 192 + (hc < 128 ? hc : 128 + rope_orig(hc - 128)); return src + (size_t)l * 384 * 1536 + col; }, WU_SCALE, 384); }
        { const float* src = P.in[I_WUKV];
          xpose8(WSP(unsigned char, WS_WUKV), 2 * 2048, 256, 2048, [=](int n) -> const float* { const int l = n / 2048, q = n - l * 2048; return src + (size_t)l * 256 * 2048 + q; }, WU_SCALE, 256); }
        { const float* src = P.in[I_WPA];
          xpose8(WSP(unsigned char, WS_WPA), 2 * 1024, 1024, 1024, [=](int n) -> const float* { const int l = n >> 10, q = n & 1023; return src + (size_t)l * 1024 * 1024 + q; }, WIN_SCALE, 1024); }
        { const float* src = P.in[I_WPB];
          xpose8(WSP(unsigned char, WS_WPB), 2 * 1024, 1024, 1024, [=](int n) -> const float* { const int l = n >> 10, q = n & 1023; return src + (size_t)l * 1024 * 1024 + q; }, WIN_SCALE, 1024); }
        { const float* src = P.in[I_WOUT];
          xpose8(WSP(unsigned char, WS_WO), 2 * 1024, 1024, 1024, [=](int n) -> const float* { const int l = n >> 10, q = n & 1023; return src + (size_t)l * 1024 * 1024 + q; }, WO_SCALE, 1024); }
        { const float* sg = P.in[I_WEG]; const float* su = P.in[I_WEU];
          xpose8(WSP(unsigned char, WS_WGU), 32 * 1024, 1024, DE, [=](int n) -> const float* { const int le = n >> 10, q = n & 1023; const int ch = 4 * (q >> 3) + (q & 3);
              return ((q & 4) ? su : sg) + (size_t)le * 1024 * DE + ch; }, WIN_SCALE, 1024); }
        { const float* src = P.in[I_WED];
          xpose8(WSP(unsigned char, WS_WD), 32 * 1024, DE, 1024, [=](int n) -> const float* { const int le = n >> 10, q = n & 1023; return src + (size_t)le * DE * 1024 + q; }, WIN_SCALE, DE); }
        { bf16_t* WSB = WSP(bf16_t, WS_WS); for (int i = bid * NT + tid; i < 2 * 8 * 128 * 128; i += G * NT) WSB[i] = f2bf(P.in[I_GMWS][i]); }
        if (DBG_REP == 0) __syncthreads(); }
    }
    { PHASE_IDS(); (void)ws; xcd_barrier(bar, tid); }

#define DBG_DUMP(k, offA, offB) do { if (DBG_STOP == (k) && g == 0 && l == 0) { PHASE_IDS(); const bf16_t* A_ = WSP(const bf16_t, offA); const bf16_t* B_ = WSP(const bf16_t, offB); \
        const size_t nA_ = (size_t)TG * 1024, nO_ = (size_t)NB * SEQ * DM; \
        for (size_t i = (size_t)bid * NT + tid; i < nO_; i += (size_t)G * NT) P.out[i] = i < nA_ ? __uint_as_float((unsigned)A_[i] << 16) : __uint_as_float((unsigned)B_[i - nA_] << 16); \
        return; } } while (0)
    for (int g = 0; g < NG; ++g) {
        if (PH(1)) {
            PHASE_IDS();
            const float* MOD = WSP(const float, WS_MOD); bf16_t* H = WSP(bf16_t, WS_H);
            LAS u32x4* ML = (LAS u32x4*)lds;
            for (int o = tid; o < 17 * 256; o += NT) { const int mr = o >> 8, ci = o & 255; const float* mp = MOD + (size_t)(mr == 16 ? 32 : g * GB + mr) * 6144 + ci * 4;
                const f32x4 sh = *(const f32x4*)mp, sc = *(const f32x4*)(mp + 1024); u32x4 w;
                w.x = cvt_pk_bf16(sh[0], sh[1]); w.y = cvt_pk_bf16(sh[2], sh[3]); w.z = cvt_pk_bf16(1.0f + sc[0], 1.0f + sc[1]); w.w = cvt_pk_bf16(1.0f + sc[2], 1.0f + sc[3]); ML[o] = w; }
            __syncthreads();
            REPS(1)
            for (int r0 = bid * 8 + wid; r0 < TG; r0 += 4 * G * 8) {
                f32x4 xv[4][4];
#pragma unroll
                for (int k = 0; k < 4; ++k) { const int rq = r0 + k * G * 8; const int r = rq < TG ? rq : r0;
                    const int bl = r / RPB, rr = r - bl * RPB, gb = g * GB + bl;
                    const float* src = rr < CTX ? P.in[I_CTX] + ((size_t)gb * CTX + rr) * 1024 : P.in[I_X] + ((size_t)gb * SEQ + (rr - CTX)) * 1024;
#pragma unroll
                    for (int i = 0; i < 4; ++i) xv[k][i] = *(const f32x4*)(src + i * 256 + lane * 4); }
#pragma unroll
                for (int k = 0; k < 4; ++k) { const int r = r0 + k * G * 8;
                    if (r < TG) { const int bl = r / RPB, rr = r - bl * RPB; const int mo = (rr < CTX ? 16 : bl) * 256 + lane;
#pragma unroll
                        for (int i = 0; i < 4; ++i) { const int c = i * 256 + lane * 4; const u32x4 m = ML[mo + i * 64];
                            const f32x4 sh = {bf_lo(m.x), bf_hi(m.x), bf_lo(m.y), bf_hi(m.y)}, sc1 = {bf_lo(m.z), bf_hi(m.z), bf_lo(m.w), bf_hi(m.w)};
                            const f32x4 h = xv[k][i] * sc1 + sh; *(unsigned*)((unsigned char*)H + (size_t)r * 1024 + c) = cvt_pk4_fp8(h[0], h[1], h[2], h[3]); } }
                }
            }
            __syncthreads();
        }
        if ((DBG_STOP == 21 || DBG_STOP == 24) && g == 0) { PHASE_IDS(); unsigned* zz = WSP(unsigned, WS_Z); for (size_t i = (size_t)bid * NT + tid; i < (size_t)TG * 2048 * 2 * 2 / 4; i += (size_t)G * NT) zz[i] = 0x7fc07fc0u; }
        { PHASE_IDS(); (void)ws; xcd_barrier(bar, tid); }

        for (int l = 0; l < DEPTH; ++l) {
            const int last = (l == DEPTH - 1) ? 1 : 0;
            if (PH(2)) {
                PHASE_IDS();
                if (bid == 0 && tid < 16) __hip_atomic_store(WSP(unsigned, WS_CTL) + CW_CNT + tid, 0u, __ATOMIC_RELAXED, __HIP_MEMORY_SCOPE_AGENT);
                if ((DBG_STOP == 13 || DBG_STOP == 23 || DBG_STOP == 24) && bid == 0 && tid == 0) __hip_atomic_store(WSP(unsigned, WS_CTL) + CW_CNT + 33, 0xffffffffu, __ATOMIC_RELAXED, __HIP_MEMORY_SCOPE_AGENT);
                Gemm gm{ws + WS_H, WSP(const bf16_t, WS_WIN) + (size_t)l * NIN * 512, 512}; DenseOrder S;   S.init(last ? GB * 8 : NPAN, NIN / 256, G, bid, last, last ? 2 : 0, 8);
                EpiIn E{WSP(bf16_t, WS_Z), WSP(float, WS_MID), WSP(bf16_t, WS_GT), P.in[I_BMERGE] + l * 2048};
                pg8::gemm_phase<EpiIn, DenseOrder, true>(lds, gm, S, E, tid);
            }
            { PHASE_IDS(); (void)ws; xcd_barrier(bar, tid); }
            DBG_DUMP(2, WS_Z, WS_GT);
            if (DBG_STOP == 24 && g == 0 && l == 0) {
                { PHASE_IDS(); const unsigned* gw = WSP(const unsigned, WS_GT); unsigned cnt = 0, fb = 0xffffffffu;
                  for (size_t i = (size_t)bid * NT + tid; i < (size_t)NB * SEQ * DM; i += (size_t)G * NT) P.out[i] = 0.f;
                  for (size_t i = (size_t)bid * NT + tid; i < (size_t)TG * 1024; i += (size_t)G * NT) if (gw[i] != 0x7fc07fc0u) { ++cnt; fb = fb < (unsigned)i ? fb : (unsigned)i; }
                  if (cnt) atomicAdd(WSP(unsigned, WS_CTL) + CW_CNT + 32, cnt); atomicMin(WSP(unsigned, WS_CTL) + CW_CNT + 33, fb); }
                { PHASE_IDS(); (void)ws; xcd_barrier(bar, tid); }
                { PHASE_IDS(); if (bid == 0 && tid == 0) { const unsigned cnt = __hip_atomic_load(WSP(unsigned, WS_CTL) + CW_CNT + 32, __ATOMIC_RELAXED, __HIP_MEMORY_SCOPE_AGENT), fb = __hip_atomic_load(WSP(unsigned, WS_CTL) + CW_CNT + 33, __ATOMIC_RELAXED, __HIP_MEMORY_SCOPE_AGENT);
                      P.out[0] = DBG_SEL == 0 ? 10.f * (float)cnt : DBG_SEL == 1 ? 100.f * (float)(fb >> 10) : 100.f * (float)(fb & 1023); } }
                return; }
            if (DBG_STOP == 23 && g == 0 && l == 0) {
                { PHASE_IDS(); const bf16_t* Gp = WSP(const bf16_t, WS_GT); unsigned nn = 0, mx = 0, fb = 0xffffffffu;
                  for (size_t i = (size_t)bid * NT + tid; i < (size_t)NB * SEQ * DM; i += (size_t)G * NT) P.out[i] = 0.f;
                  for (size_t i = (size_t)bid * NT + tid; i < (size_t)TG * 2048; i += (size_t)G * NT) { const float v = __uint_as_float((unsigned)Gp[i] << 16);
                      if (v != v) ++nn; else { const unsigned b = __float_as_uint(fabsf(v)); mx = mx > b ? mx : b; }
                      if (!(fabsf(v) <= 2.f)) fb = fb < (unsigned)i ? fb : (unsigned)i; }
                  if (nn) atomicAdd(WSP(unsigned, WS_CTL) + CW_CNT + 32, nn); atomicMax(WSP(unsigned, WS_CTL) + CW_CNT + 34, mx); atomicMin(WSP(unsigned, WS_CTL) + CW_CNT + 33, fb); }
                { PHASE_IDS(); (void)ws; xcd_barrier(bar, tid); }
                { PHASE_IDS(); if (bid == 0 && tid == 0) { const unsigned nn = __hip_atomic_load(WSP(unsigned, WS_CTL) + CW_CNT + 32, __ATOMIC_RELAXED, __HIP_MEMORY_SCOPE_AGENT), mx = __hip_atomic_load(WSP(unsigned, WS_CTL) + CW_CNT + 34, __ATOMIC_RELAXED, __HIP_MEMORY_SCOPE_AGENT), fb = __hip_atomic_load(WSP(unsigned, WS_CTL) + CW_CNT + 33, __ATOMIC_RELAXED, __HIP_MEMORY_SCOPE_AGENT);
                      P.out[0] = DBG_SEL == 0 ? (nn ? 1e7f + (float)nn : 10.f * __uint_as_float(mx)) : DBG_SEL == 1 ? 100.f * (float)(fb >> 11) : 100.f * (float)(fb & 2047); } }
                return; }
            if (DBG_STOP == 22 && g == 0 && l == 0) {
                { PHASE_IDS(); const bf16_t* Zp = WSP(const bf16_t, DBG_SEL >= 2 ? WS_GT : WS_Z); unsigned* flagsR = WSP(unsigned, WS_KV); unsigned* flagsC = flagsR + TG;
                  for (size_t i = (size_t)bid * NT + tid; i < (size_t)TG + 2048; i += (size_t)G * NT) flagsR[i] = 0u;
                  for (size_t i = (size_t)bid * NT + tid; i < (size_t)NB * SEQ * DM; i += (size_t)G * NT) P.out[i] = 0.f; }
                { PHASE_IDS(); (void)ws; xcd_barrier(bar, tid); }
                { PHASE_IDS(); const bf16_t* Zp = WSP(const bf16_t, DBG_SEL >= 2 ? WS_GT : WS_Z); unsigned* flagsR = WSP(unsigned, WS_KV); unsigned* flagsC = flagsR + TG;
                  for (size_t i = (size_t)bid * NT + tid; i < (size_t)TG * 2048; i += (size_t)G * NT) { const float v = __uint_as_float((unsigned)Zp[i] << 16);
                      if (!(fabsf(v) <= (DBG_SEL >= 2 ? 2.f : 50.f))) { atomicOr(flagsR + (i >> 11), 1u); atomicOr(flagsC + (i & 2047), 1u); } } }
                { PHASE_IDS(); (void)ws; xcd_barrier(bar, tid); }
                { PHASE_IDS(); const unsigned* flagsR = WSP(const unsigned, WS_KV); const unsigned* flagsC = flagsR + TG; unsigned nr = 0, nc = 0;
                  for (size_t i = (size_t)bid * NT + tid; i < (size_t)TG; i += (size_t)G * NT) nr += __hip_atomic_load(flagsR + i, __ATOMIC_RELAXED, __HIP_MEMORY_SCOPE_AGENT);
                  for (size_t i = (size_t)bid * NT + tid; i < 2048; i += (size_t)G * NT) nc += __hip_atomic_load(flagsC + i, __ATOMIC_RELAXED, __HIP_MEMORY_SCOPE_AGENT);
                  if (nr) atomicAdd(WSP(unsigned, WS_CTL) + CW_CNT + 32, nr); if (nc) atomicAdd(WSP(unsigned, WS_CTL) + CW_CNT + 34, nc); }
                { PHASE_IDS(); (void)ws; xcd_barrier(bar, tid); }
                { PHASE_IDS(); if (bid == 0 && tid == 0) { const unsigned nr = __hip_atomic_load(WSP(unsigned, WS_CTL) + CW_CNT + 32, __ATOMIC_RELAXED, __HIP_MEMORY_SCOPE_AGENT), nc = __hip_atomic_load(WSP(unsigned, WS_CTL) + CW_CNT + 34, __ATOMIC_RELAXED, __HIP_MEMORY_SCOPE_AGENT);
                      P.out[0] = (DBG_SEL & 1) ? (float)nc * 100.f : (float)nr * 100.f; } }
                return; }
            if (DBG_STOP == 21 && g == 0 && l == 0) {
                { PHASE_IDS(); const unsigned* zw = WSP(const unsigned, WS_Z); unsigned cz = 0, cg = 0; const size_t nz = (size_t)TG * 2048 * 2 / 4;
                  for (size_t i = (size_t)bid * NT + tid; i < 2 * nz; i += (size_t)G * NT) if (zw[i] == 0x7fc07fc0u) { if (i < nz) ++cz; else ++cg; }
                  for (size_t i = (size_t)bid * NT + tid; i < (size_t)NB * SEQ * DM; i += (size_t)G * NT) P.out[i] = 0.f;
                  if (cz) atomicAdd(WSP(unsigned, WS_CTL) + CW_CNT + 32, cz); if (cg) atomicAdd(WSP(unsigned, WS_CTL) + CW_CNT + 34, cg); }
                { PHASE_IDS(); (void)ws; xcd_barrier(bar, tid); }
                { PHASE_IDS(); if (bid == 0 && tid == 0) { P.out[0] = (float)__hip_atomic_load(WSP(unsigned, WS_CTL) + CW_CNT + 32, __ATOMIC_RELAXED, __HIP_MEMORY_SCOPE_AGENT);
                      P.out[1] = 3.0f * (float)__hip_atomic_load(WSP(unsigned, WS_CTL) + CW_CNT + 34, __ATOMIC_RELAXED, __HIP_MEMORY_SCOPE_AGENT); } }
                return; }
            if (PH(3)) {
                PHASE_IDS();
                const bf16_t* MID = WSP(const bf16_t, WS_MID); unsigned char* QN = WSP(unsigned char, WS_QN); unsigned char* KVN = WSP(unsigned char, WS_KVN); bf16_t* KR = WSP(bf16_t, WS_KR);
                const bf16_t* Z = WSP(const bf16_t, WS_Z); float* STAT = WSP(float, WS_WT);
                const float* RCOS = WSP(const float, WS_ROPE); const float* RSIN = RCOS + 2048 * 32;
                const float* qn_g = P.in[I_QNORM] + l * QLORA; const float* kvn_g = P.in[I_KVNORM] + l * KVLORA;
                const f32x4 kvg = *(const f32x4*)(kvn_g + lane * 4), qg4 = *(const f32x4*)(qn_g + lane * 4); const f32x2 qg2 = *(const f32x2*)(qn_g + 256 + lane * 2);
                constexpr int NR = 4;
                u32x2 kvw[NR], qaw[NR]; unsigned qbw[NR], krw[NR]; u32x4 zw[NR]; float csw[NR], snw[NR];
#define P2A_FETCH(blk_, KV, QA, QB, KR, ZW) do { _Pragma("unroll") for (int k2 = 0; k2 < NR; ++k2) { const int r_ = (blk_) * (8 * NR) + wid * NR + k2; const bf16_t* mp_ = MID + (size_t)r_ * NMID; \
        { const int bl_ = r_ / RPB, pos_ = r_ - bl_ * RPB - CTX; const int pc_ = pos_ >= 0 ? pos_ : 0; const int i_ = 4 * (lane >> 3) + (lane & 3); csw[k2] = RCOS[pc_ * 32 + i_]; snw[k2] = RSIN[pc_ * 32 + i_]; } \
        KV[k2] = *(const u32x2*)(mp_ + lane * 4); QA[k2] = *(const u32x2*)(mp_ + 320 + lane * 4); QB[k2] = *(const unsigned*)(mp_ + 320 + 256 + lane * 2); KR[k2] = (unsigned)mp_[256 + lane]; \
        ZW[k2] = *(const u32x4*)((const unsigned char*)Z + (size_t)r_ * 2048 + 1024 + lane * 16); } } while (0)
                REPS(3) {
                for (int blk = bid; blk < TG / (8 * NR); blk += G) {
                    P2A_FETCH(blk, kvw, qaw, qbw, krw, zw);
                    asm volatile("" ::: "memory");
#pragma unroll
                for (int k2 = 0; k2 < NR; ++k2) {
                    const int r = blk * (8 * NR) + wid * NR + k2;
                    const int bl = r / RPB, rr = r - bl * RPB, pos = rr - CTX;
                    const f32x4 kv = {bf_lo(kvw[k2].x), bf_hi(kvw[k2].x), bf_lo(kvw[k2].y), bf_hi(kvw[k2].y)};
                    float s = kv[0] * kv[0] + kv[1] * kv[1] + kv[2] * kv[2] + kv[3] * kv[3]; s = wave_sum(s);
                    float rs = 1.0f / sqrtf(s * (1.0f / 256.0f) + LN_EPS);
                    { const f32x4 o = kv * rs * kvg; *(unsigned*)(KVN + (size_t)r * 256 + lane * 4) = cvt_pk4_fp8(o[0], o[1], o[2], o[3]); }
                    const f32x4 qa = {bf_lo(qaw[k2].x), bf_hi(qaw[k2].x), bf_lo(qaw[k2].y), bf_hi(qaw[k2].y)}; const f32x2 qb = {bf_lo(qbw[k2]), bf_hi(qbw[k2])};
                    s = qa[0] * qa[0] + qa[1] * qa[1] + qa[2] * qa[2] + qa[3] * qa[3] + qb[0] * qb[0] + qb[1] * qb[1]; s = wave_sum(s);
                    rs = 1.0f / sqrtf(s * (1.0f / 384.0f) + LN_EPS);
                    { const f32x4 o = qa * rs * qg4; *(unsigned*)(QN + (size_t)r * 512 + lane * 4) = cvt_pk4_fp8(o[0], o[1], o[2], o[3]);
                      const f32x2 o2 = qb * rs * qg2; *(unsigned short*)(QN + (size_t)r * 512 + 256 + lane * 2) = (unsigned short)__builtin_amdgcn_cvt_pk_fp8_f32(o2[0], o2[1], 0, false);
                      *(unsigned short*)(QN + (size_t)r * 512 + 384 + lane * 2) = (unsigned short)0; }
                    { const float v = __uint_as_float(krw[k2] << 16); const float pv = __uint_as_float((unsigned)__builtin_amdgcn_ds_swizzle((int)__float_as_uint(v), 0x101F));   float o = v;
                      if (pos >= 0) { const float cs = csw[k2], sn = snw[k2];
                          o = (lane & 4) ? (pv * sn + v * cs) : (v * cs - pv * sn); }
                      ((unsigned char*)KR)[(size_t)r * 64 + lane] = (unsigned char)__builtin_amdgcn_cvt_pk_fp8_f32(o, o, 0, false); }
                    { const u32x4 w0 = zw[k2]; float sm = 0.f, s2 = 0.f;
#define ACC2(w) { const f32x4 a = fp8x4_f32(w); sm += (a[0] + a[1]) + (a[2] + a[3]); s2 += (a[0] * a[0] + a[1] * a[1]) + (a[2] * a[2] + a[3] * a[3]); }
                      ACC2(w0.x) ACC2(w0.y) ACC2(w0.z) ACC2(w0.w)
#undef ACC2
                      sm = wave_sum(sm); s2 = wave_sum(s2); const float mean = sm * (1.0f / 1024.0f); const float var = fmaxf(s2 * (1.0f / 1024.0f) - mean * mean, 0.f);
                      if (lane == 0) { f32x2 st = {mean, 1.0f / sqrtf(var + LN_EPS)}; *(f32x2*)(STAT + 2 * (size_t)r) = st; } }
                }
                } }
#undef P2A_FETCH
            }
            { PHASE_IDS(); (void)ws; xcd_barrier(bar, tid); }
            if (PH(4)) {
                PHASE_IDS();
                const unsigned char* Z = WSP(const unsigned char, WS_Z); unsigned char* GM = WSP(unsigned char, WS_GM); const float* STAT = WSP(const float, WS_WT);
                LAS char* VN = (LAS char*)lds;
                LAS f32x4* LNL = (LAS f32x4*)(lds + 36864);
                LAS unsigned char* RAW = lds + 49152;
                LAS unsigned char* URAW = lds + 81920;
                LAS unsigned char* STS = lds + 114688;
                for (int o = tid; o < 512; o += NT) LNL[o] = *(const f32x4*)((o < 256 ? P.in[I_GMLNG] : P.in[I_GMLNB]) + l * 1024 + (o & 255) * 4);
                const float* bs = P.in[I_GMBS] + l * 8 * 128; const bf16_t* Wsl = WSP(const bf16_t, WS_WS) + (size_t)l * 8 * 128 * 128;
                const int r32 = lane & 31, hi = lane >> 5;
                const int i0 = 32 * (wid & 3), chh = wid >> 2;
                const int nun = (last ? GB * 16 : TG / 128) * 8;
#define GM_ROW0(un) ((size_t)(last ? (((un) >> 3) >> 4) * 18 + 2 + (((un) >> 3) & 15) : ((un) >> 3)) * 128)
#define GM_DMA(un, b) do { const size_t row0_ = GM_ROW0(un); const unsigned char* zr_ = Z + (row0_ + (tid >> 3)) * 2048 + ((un) & 7) * 128; \
        const unsigned char* zv_ = zr_ + 1024 + (tid & 7) * 16; const unsigned char* zu_ = zr_ + (((tid & 7) ^ ((tid >> 3) & 7)) * 16); \
        __builtin_amdgcn_global_load_lds((const unsigned*)zv_, (LAS unsigned*)(RAW + (b) * 16384 + wid * 1024), 16, 0, 0); \
        __builtin_amdgcn_global_load_lds((const unsigned*)(zv_ + (size_t)64 * 2048), (LAS unsigned*)(RAW + (b) * 16384 + 8192 + wid * 1024), 16, 0, 0); \
        __builtin_amdgcn_global_load_lds((const unsigned*)zu_, (LAS unsigned*)(URAW + (b) * 16384 + wid * 1024), 16, 0, 0); \
        __builtin_amdgcn_global_load_lds((const unsigned*)(zu_ + (size_t)64 * 2048), (LAS unsigned*)(URAW + (b) * 16384 + 8192 + wid * 1024), 16, 0, 0); \
        __builtin_amdgcn_global_load_lds((const unsigned*)(STAT + 2 * (row0_ + 2 * lane)), (LAS unsigned*)(STS + (b) * 8192 + wid * 1024), 16, 0, 0); } while (0)
#define GM_LDW(gi_) do { const bf16_t* wp = Wsl + ((size_t)(gi_) * 128 + i0 + r32) * 128 + hi * 8; \
        _Pragma("unroll") for (int t2 = 0; t2 < 2; ++t2) _Pragma("unroll") for (int ks = 0; ks < 4; ++ks) pa[t2][ks] = *reinterpret_cast<const bf16x8*>(wp + t2 * 64 + ks * 16); \
        bsi = bs[(gi_) * 128 + i0 + r32]; __builtin_amdgcn_s_waitcnt(0x0F70);   } while (0)
                REPS(4) {
                __syncthreads();
                bf16x8 pa[2][4]; float bsi; int cur_gi = bid & 7;
                GM_LDW(cur_gi);
                int un = bid, kb = 0; if (un < nun) GM_DMA(un, 0);
                for (; un < nun; un += G, kb ^= 1) {
                    const int gi = un & 7; const size_t row0 = GM_ROW0(un);
                    if (gi != cur_gi) { cur_gi = gi; GM_LDW(gi); }
                    if (un + G < nun) { GM_DMA(un + G, kb ^ 1); } else { GM_DMA(un, kb ^ 1); }
                    asm volatile("s_waitcnt vmcnt(5)" ::: "memory"); __builtin_amdgcn_s_barrier();
#pragma unroll
                    for (int i = 0; i < 4; ++i) { const int idx = tid + NT * i, j = idx >> 4, c8 = (idx & 15) * 8; const int cg4 = (gi * 128 + c8) >> 2;
                        const u32x2 w = *(const LAS u32x2*)(RAW + kb * 16384 + j * 128 + c8); const f32x2 st = *(const LAS f32x2*)(STS + kb * 8192 + wid * 1024 + j * 8);
                        const float mean = st[0], rstd = st[1];
                        const f32x4 g0 = LNL[cg4], g1 = LNL[cg4 + 1], b0 = LNL[256 + cg4], b1 = LNL[256 + cg4 + 1];
                        f32x4 v0 = fp8x4_f32(w.x), v1 = fp8x4_f32(w.y);
                        v0 = (v0 - mean) * rstd * g0 + b0; v1 = (v1 - mean) * rstd * g1 + b1;
                        u32x4 o; o.x = cvt_pk_bf16(v0[0], v0[1]); o.y = cvt_pk_bf16(v0[2], v0[3]); o.z = cvt_pk_bf16(v1[0], v1[1]); o.w = cvt_pk_bf16(v1[2], v1[3]);
                        *(LAS u32x4*)(VN + (j >> 6) * 16384 + att::v_st(j & 63, c8)) = o; }
                    asm volatile("s_waitcnt lgkmcnt(0)" ::: "memory"); __builtin_amdgcn_s_barrier();
                    f32x16 o2[2] = {};
                    const int vb = (int)(uintptr_t)VN + att::v_rd_base(lane) + chh * 1024;
#pragma unroll
                    for (int t2 = 0; t2 < 2; ++t2) { att::pv_one_t<0>(o2[0], vb + t2 * 16384, pa[t2][0], pa[t2][1], pa[t2][2], pa[t2][3]); att::pv_one_t<1>(o2[1], vb + t2 * 16384, pa[t2][0], pa[t2][1], pa[t2][2], pa[t2][3]); }
                    unsigned char* gp = GM + (row0 + i0 + r32) * 1024 + gi * 128 + chh * 64 + 4 * hi;
                    const LAS unsigned char* ul = URAW + kb * 16384 + (i0 + r32) * 128 + 4 * hi; const int usw = (i0 + r32) & 7;
#pragma unroll
                    for (int dd = 0; dd < 2; ++dd)
#pragma unroll
                        for (int q = 0; q < 4; ++q) { const int bo = chh * 64 + dd * 32 + q * 8;
                            const f32x4 u4 = fp8x4_f32(*(const LAS unsigned*)(ul + (((bo >> 4) ^ usw) << 4) + (bo & 15)));
                            *(unsigned*)(gp + dd * 32 + q * 8) = cvt_pk4_fp8(u4[0] * (o2[dd][4 * q + 0] + bsi), u4[1] * (o2[dd][4 * q + 1] + bsi), u4[2] * (o2[dd][4 * q + 2] + bsi), u4[3] * (o2[dd][4 * q + 3] + bsi)); }
                    asm volatile("s_waitcnt lgkmcnt(0)" ::: "memory"); __builtin_amdgcn_s_barrier();
                }
                asm volatile("s_waitcnt vmcnt(0)" ::: "memory"); __syncthreads(); }
#undef GM_LDW
#undef GM_DMA
#undef GM_ROW0
            }
            if (PH(5)) { PHASE_IDS();
              Gemm gm{ws + WS_QN, WSP(const bf16_t, WS_WUQ) + (size_t)l * 1536 * 256, 256}; DenseOrder S; S.init(last ? GB * 8 : NPAN, 6, G, bid, last);
              EpiQ E{WSP(bf16_t, WS_MID), WSP(const float, WS_ROPE), WSP(const float, WS_ROPE) + 2048 * 32, 1.0f / WU_SCALE};
              pg8::gemm_phase<EpiQ, DenseOrder, true>(lds, gm, S, E, tid); }
            if (PH(6)) { PHASE_IDS();
              Gemm gm{ws + WS_KVN, WSP(const bf16_t, WS_WUKV) + (size_t)l * 2048 * 128, 128}; DenseOrder S; S.init(NPAN, 8, G, G - 1 - bid);
              EpiStore E{WSP(unsigned char, WS_KV), 2048, 1.0f / WU_SCALE, WSP(unsigned char, WS_MID) + (size_t)TG * 1536};
              pg8::gemm_phase<EpiStore, DenseOrder, true>(lds, gm, S, E, tid); }
            { PHASE_IDS(); (void)ws; xcd_barrier(bar, tid); }
            DBG_DUMP(4, WS_Z, WS_KV);
            if (PH(7)) {
                PHASE_IDS();
                const unsigned char* QB = WSP(const unsigned char, WS_MID);     bf16_t* ATT = WSP(bf16_t, WS_Z + (size_t)TG * 2048);
                const int vc = (G % 8 == 0) ? (bid % 8) * (G / 8) + bid / 8 : bid;
                const int nheavy = GB * NH * 8, nlight = last ? 0 : GB * NH;
                const bool spread = G >= 64 + GB * NH; int lj = spread ? bid - 64 : vc;
                REPS(7)
                for (int it = 0; ; ++it) {
                    int u = vc + it * G;
                    if (u >= nheavy) { if (lj < 0 || lj >= nlight) break; u = nheavy + lj; lj = spread ? -1 : lj + G; }
                    int bl, h, qb, ntile;
                    if (u < nheavy) { const int bh = u >> 3; bl = bh >> 3; h = bh & 7; qb = 1 + (u & 7); ntile = RPB / 64; }
                    else { const int bh = u - nheavy; bl = bh >> 3; h = bh & 7; qb = 0; ntile = CTX / 64; }
                    const size_t rb = (size_t)bl * RPB;
                    att::attn_body(QB + (rb + qb * 256) * 1536 + h * 192, ws, (unsigned)(WS_KV + ((rb >> 6) * 8 + h) * 8192), (unsigned)(WS_MID + (size_t)TG * 1536 + rb * 1024 + h * 128), (unsigned)(WS_KR + rb * 64), (bf16_t*)((unsigned char*)ATT + (rb + qb * 256) * 1024 + h * 128), ntile, (LAS char*)lds, tid);
                }
            }
            if (PH(8)) { PHASE_IDS();
              Gemm gm{ws + WS_GM, WSP(const bf16_t, WS_WPA) + (size_t)l * 1024 * 512, 512}; DenseOrder S; S.init(last ? GB * 8 : NPAN, 4, G, bid, last);
              EpiProj<false> E{WSP(bf16_t, WS_GT + (size_t)TG * 2048), WSP(const bf16_t, WS_GT), 0, nullptr, 1.0f / WIN_SCALE};
              pg8::gemm_phase<EpiProj<false>, DenseOrder, true>(lds, gm, S, E, tid); }
            { PHASE_IDS(); (void)ws; xcd_barrier(bar, tid); }
            if (PH(9)) { PHASE_IDS();
              Gemm gm{ws + WS_Z + (size_t)TG * 2048, WSP(const bf16_t, WS_WPB) + (size_t)l * 1024 * 512, 512}; DenseOrder S; S.init(last ? GB * 8 : NPAN, 4, G, bid, last);
              EpiProj<true> E{WSP(bf16_t, WS_GT + (size_t)TG * 2048), WSP(const bf16_t, WS_GT), 1024, WSP(unsigned char, WS_GM) + (size_t)TG * 1024, 1.0f / (WIN_SCALE * ATT_SCALE)};
              pg8::gemm_phase<EpiProj<true>, DenseOrder, true>(lds, gm, S, E, tid); }
            { PHASE_IDS(); (void)ws; xcd_barrier(bar, tid); }
            DBG_DUMP(6, WS_H, WS_GT);
            if (DBG_STOP == 20 && g == 0 && l == 0) { PHASE_IDS(); const bf16_t* GTp = WSP(const bf16_t, WS_GT);
                for (size_t i = (size_t)bid * NT + tid; i < (size_t)NB * SEQ * DM; i += (size_t)G * NT) { const size_t row = i >> 10, col = i & 1023; float v = 0.f;
                    if (row < (size_t)TG) v = __uint_as_float((unsigned)GTp[row * 2048 + DBG_COL0 + col] << 16); P.out[i] = 100.f * v; }
                return; }
            if (PH(10)) { PHASE_IDS();
              Gemm gm{ws + WS_GM + (size_t)TG * 1024, WSP(const bf16_t, WS_WO) + (size_t)l * 1024 * 512, 512}; DenseOrder S; S.init(last ? GB * 8 : NPAN, 4, G, bid, last);
              EpiOut E{WSP(bf16_t, WS_LAT), P.in[I_X], P.in[I_CTX], WSP(const float, WS_MOD) + (size_t)l * 33 * 6144, g, l == 0 ? 1 : 0};
              pg8::gemm_phase<EpiOut, DenseOrder, true>(lds, gm, S, E, tid); }
            { PHASE_IDS(); (void)ws; xcd_barrier(bar, tid); }
            DBG_DUMP(8, WS_H, WS_GM);
            if (PH(11)) {
                PHASE_IDS();
                bf16_t* LAT = WSP(bf16_t, WS_LAT); bf16_t* H = WSP(bf16_t, WS_H);
                const float* mod = WSP(const float, WS_MOD) + (size_t)l * 33 * 6144;
                LAS f32x4* WR = (LAS f32x4*)lds;
                LAS int* ENT = (LAS int*)(lds + 65536);
                for (int o = tid; o < 64 * 64; o += NT) { const int ln = o & 15, q = o >> 4, e4 = q & 3, j = (q >> 2) & 3, i = q >> 4; const int k = 64 * i + 4 * ln + j;
                    WR[o] = *(const f32x4*)(P.in[I_WROUTER] + (size_t)k * 16 + 4 * e4); }
                LAS f32x4* LNL = (LAS f32x4*)(lds + 114688);
                for (int o = tid; o < 512; o += NT) LNL[o] = *(const f32x4*)((o < 256 ? P.in[I_LN1G] : P.in[I_LN1B]) + l * 1024 + (o & 255) * 4);
                __syncthreads();
                const float* brt = P.in[I_BROUTER];
                int nrows3 = 0; for (int r = bid * 8; r < TG; r += G * 8) nrows3 += (TG - r) < 8 ? (TG - r) : 8;
                REPS(11) {
                for (int it = 0; it * 32 < nrows3; ++it) {
                    int lane = tid & 63; asm volatile("" : "+v"(lane));
                    const int q = lane >> 4, l16 = lane & 15; const int lr = it * 32 + wid * 4 + q;
                    const int r = (lr >> 3) * (G * 8) + bid * 8 + (lr & 7);
                    bool ok = lr < nrows3 && r < TG;
                    if (ok && last && (r % RPB) < CTX) { ok = false; if (l16 == 0) { ENT[(2 * lr) * 4] = -1; ENT[(2 * lr + 1) * 4] = -1; } }
                    if (ok) {
                        const int mr = row_mod(r, g); const float* md = mod + (size_t)mr * 6144;
                        bf16_t* lp = LAT + (size_t)r * 1024;
                        f32x4 v[16]; float sm = 0.f;
#pragma unroll
                        for (int i = 0; i < 16; ++i) { const u32x2 w = *(const u32x2*)(lp + i * 64 + l16 * 4); v[i] = (f32x4){bf_lo(w.x), bf_hi(w.x), bf_lo(w.y), bf_hi(w.y)}; sm += (v[i][0] + v[i][1]) + (v[i][2] + v[i][3]); }
                        sm = row_sum16(sm); const float mean = sm * (1.0f / 1024.0f); float qv = 0.f;
#pragma unroll
                        for (int i = 0; i < 16; ++i) { v[i] = v[i] - mean; qv += (v[i][0] * v[i][0] + v[i][1] * v[i][1]) + (v[i][2] * v[i][2] + v[i][3] * v[i][3]); }
                        qv = row_sum16(qv); const float rstd = 1.0f / sqrtf(qv * (1.0f / 1024.0f) + LN_EPS);
                        f32x4 lg4[4] = {};
                        f32x4 pc[2], ps[2];
#pragma unroll
                        for (int i = 0; i < 2; ++i) { pc[i] = *(const f32x4*)(md + 4096 + i * 64 + l16 * 4); ps[i] = *(const f32x4*)(md + 3072 + i * 64 + l16 * 4); }
#pragma unroll
                        for (int i = 0; i < 16; ++i) { const int c = i * 64 + l16 * 4;
                            const f32x4 csc = pc[i & 1], csh = ps[i & 1];
                            if (i + 2 < 16) { pc[i & 1] = *(const f32x4*)(md + 4096 + c + 128); ps[i & 1] = *(const f32x4*)(md + 3072 + c + 128); }
                            const f32x4 o = v[i] * rstd * LNL[i * 16 + l16] + LNL[256 + i * 16 + l16];
                            const f32x4 h2 = o * (1.0f + csc) + csh;
                            *(unsigned*)((unsigned char*)H + (size_t)r * 1024 + c) = cvt_pk4_fp8(h2[0], h2[1], h2[2], h2[3]);
                            f32x4 wv[16];
#pragma unroll
                            for (int q = 0; q < 16; ++q) wv[q] = WR[(i * 16 + q) * 16 + l16];
#pragma unroll
                            for (int j = 0; j < 4; ++j)
#pragma unroll
                                for (int e4 = 0; e4 < 4; ++e4) lg4[e4] = h2[j] * wv[j * 4 + e4] + lg4[e4];
                            asm volatile("" ::: "memory"); }
                        float lgt[16];
#pragma unroll
                        for (int e = 0; e < 16; ++e) lgt[e] = lg4[e >> 2][e & 3];
                        float aff[16], sel[16];
#pragma unroll
                        for (int e = 0; e < 16; ++e) { const float t = row_sum16(lgt[e]); aff[e] = fsigmoid(t); sel[e] = aff[e] + brt[e]; }
                        int grp = 0; float best = -1e30f;
#pragma unroll
                        for (int gq = 0; gq < 4; ++gq) { float m1 = -1e30f, m2 = -1e30f;
#pragma unroll
                            for (int j = 0; j < 4; ++j) { const float x = sel[4 * gq + j]; if (x > m1) { m2 = m1; m1 = x; } else if (x > m2) m2 = x; }
                            const float sc = m1 + m2; if (sc > best) { best = sc; grp = gq; } }
                        float s4[4], a4[4];
#pragma unroll
                        for (int j = 0; j < 4; ++j) { s4[j] = grp == 0 ? sel[j] : grp == 1 ? sel[4 + j] : grp == 2 ? sel[8 + j] : sel[12 + j]; a4[j] = grp == 0 ? aff[j] : grp == 1 ? aff[4 + j] : grp == 2 ? aff[8 + j] : aff[12 + j]; }
                        int i0 = 0; float b0 = s4[0];
#pragma unroll
                        for (int j = 1; j < 4; ++j) if (s4[j] > b0) { b0 = s4[j]; i0 = j; }
                        int i1 = -1; float b1 = -1e30f;
#pragma unroll
                        for (int j = 0; j < 4; ++j) if (j != i0 && s4[j] > b1) { b1 = s4[j]; i1 = j; }
                        const float w0 = i0 == 0 ? a4[0] : i0 == 1 ? a4[1] : i0 == 2 ? a4[2] : a4[3], w1 = i1 == 0 ? a4[0] : i1 == 1 ? a4[1] : i1 == 2 ? a4[2] : a4[3];
                        const float inv = 1.0f / (w0 + w1);
                        if (l16 == 0) { const int e0 = grp * 4 + i0, e1 = grp * 4 + i1;
                            ENT[(2 * lr) * 4 + 0] = e0; ENT[(2 * lr) * 4 + 1] = 2 * r; ENT[(2 * lr + 1) * 4 + 0] = e1; ENT[(2 * lr + 1) * 4 + 1] = 2 * r + 1;
                            float* wtl = WSP(float, WS_WT) + (size_t)bid * WGSTR + 2 * lr; wtl[0] = w0 * inv; wtl[1] = w1 * inv; }
                    }
                }
                __syncthreads();
                { int nrows = 0; for (int r = bid * 8; r < TG; r += G * 8) nrows += (TG - r) < 8 ? (TG - r) : 8;
                  LAS int* WC = (LAS int*)(lds + 65536 + 32768);
                  const int ln = tid & 63; const int n = tid; const int e = n < 2 * nrows ? ENT[n * 4] : -1; int myrank = 0;
#pragma unroll
                  for (int ee = 0; ee < 16; ++ee) { const unsigned long long mask = __ballot(e == ee); if (e == ee) myrank = __popcll(mask & ((1ull << ln) - 1ull)); if (ln == 0) WC[wid * 16 + ee] = __popcll(mask); }
                  __syncthreads();
                  if (tid < 16) { int run = 0;
#pragma unroll
                      for (int w = 0; w < 8; ++w) { const int c = WC[w * 16 + tid]; WC[w * 16 + tid] = run; run += c; } WC[128 + tid] = run; }
                  __syncthreads();
                  if (e >= 0) ENT[n * 4 + 3] = WC[wid * 16 + e] + myrank;
                  if (tid < 32) __hip_atomic_store(WSP(int, WS_CTL + 32768) + bid * 32 + tid, tid < 16 ? WC[128 + tid] : 0, __ATOMIC_RELAXED, __HIP_MEMORY_SCOPE_AGENT); }
                if (DBG_REP == 11) __syncthreads(); }
            }
            { PHASE_IDS(); (void)ws; xcd_barrier(bar, tid); }
            DBG_DUMP(9, WS_H, WS_GM);
            if (PH(11)) {
                PHASE_IDS();
                LAS int* ENT = (LAS int*)(lds + 65536);
                LAS int* CL = (LAS int*)(lds + 65536 + 16384);
                const int* WGC = WSP(const int, WS_CTL + 32768);
                REPS(12) {
                if (tid < 32) CL[tid] = 0;
                __syncthreads();
                for (int o = tid; o < G * 16; o += NT) { const int b = o >> 4, e = o & 15; const int c = __hip_atomic_load(WGC + b * 32 + e, __ATOMIC_RELAXED, __HIP_MEMORY_SCOPE_AGENT);
                    if (c) { if (b < bid) __hip_atomic_fetch_add(&CL[e], c, __ATOMIC_RELAXED, __HIP_MEMORY_SCOPE_WORKGROUP); __hip_atomic_fetch_add(&CL[16 + e], c, __ATOMIC_RELAXED, __HIP_MEMORY_SCOPE_WORKGROUP); } }
                __syncthreads();
                if (tid == 0) { int a = 0, sb = 0; for (int e = 0; e < 16; ++e) { const int n = CL[16 + e]; PRE[e] = a; PRE[17 + e] = n; PRE[33 + e] = sb; a += (n + 255) >> 8; sb += n; } PRE[16] = a; }
                __syncthreads();
                int nrows = 0; for (int r = bid * 8; r < TG; r += G * 8) nrows += (TG - r) < 8 ? (TG - r) : 8;
                for (int n = tid; n < 2 * nrows; n += NT) { const int e = ENT[n * 4]; if (e >= 0) ENT[n * 4 + 3] += PRE[33 + e] + CL[e]; }
                __syncthreads();
                int* SLT = WSP(int, WS_LIST) + (size_t)bid * WGSTR;
                for (int n = tid; n < 2 * nrows; n += NT) SLT[n] = ENT[n * 4 + 3];
                const unsigned char* H = WSP(const unsigned char, WS_H); unsigned char* HS = WSP(unsigned char, WS_KV);
                for (int n0 = wid * 8; n0 < 2 * nrows; n0 += 64) {
                    u32x4 cv[8]; int csl[8];
#pragma unroll
                    for (int k = 0; k < 8; ++k) { const int n = n0 + k; const bool okc = n < 2 * nrows && ENT[(n < 2 * nrows ? n : 0) * 4] >= 0; const int nn = okc ? n : 0;
                        const int a = ENT[nn * 4 + 1]; csl[k] = okc ? ENT[nn * 4 + 3] : -1;
                        cv[k] = ((const u32x4*)(H + (size_t)((okc ? a : 0) >> 1) * 1024))[lane]; }
                    asm volatile("" ::: "memory");
#pragma unroll
                    for (int k = 0; k < 8; ++k) if (csl[k] >= 0) ((u32x4*)(HS + (size_t)csl[k] * 1024))[lane] = cv[k];
                    asm volatile("" ::: "memory"); }
                if (DBG_REP == 12 && rep_ == 0) { __syncthreads(); for (int n = tid; n < 2 * nrows; n += NT) { const int e = ENT[n * 4]; if (e >= 0) ENT[n * 4 + 3] -= PRE[33 + e] + CL[e]; } __syncthreads(); } }
            }
            { PHASE_IDS(); (void)ws; xcd_barrier(bar, tid); }
            if (DBG_STOP == 16 && g == 0 && l == 0) { PHASE_IDS(); const float* WSL = WSP(const float, WS_WT); const int* SLOT = WSP(const int, WS_LIST);
                for (size_t i = (size_t)bid * NT + tid; i < (size_t)NB * SEQ * DM; i += (size_t)G * NT) P.out[i] = i < (size_t)2 * TG ? WSL[i] : i < (size_t)4 * TG ? (float)SLOT[i - 2 * TG] * 1e-3f : 0.f;
                return; }
            if (PH(12)) { PHASE_IDS();
              Gemm gm{ws + WS_KV, WSP(const bf16_t, WS_WGU) + (size_t)l * 16 * 1024 * 512, 512}; MoeOrder S{PRE, G, bid};
              EpiGU E{WSP(bf16_t, WS_GT), PRE};
              pg8::gemm_phase<EpiGU, MoeOrder, true>(lds, gm, S, E, tid); }
            { PHASE_IDS(); (void)ws; xcd_barrier(bar, tid); }
            DBG_DUMP(10, WS_GT, WS_GM);
            if (PH(13)) { PHASE_IDS();
              Gemm gm{ws + WS_GT, WSP(const bf16_t, WS_WD) + (size_t)l * 16 * 1024 * (DE / 2), DE / 2}; MoeOrder S{PRE, G, bid};
              EpiDown E{WSP(bf16_t, WS_Z), PRE};
              pg8::gemm_phase<EpiDown, MoeOrder, true>(lds, gm, S, E, tid); }
            { PHASE_IDS(); (void)ws; xcd_barrier(bar, tid); }
            DBG_DUMP(11, WS_Z, WS_Z + (size_t)TG * 1024 * 2);
            if (PH(14)) {
                PHASE_IDS();
                bf16_t* LAT = WSP(bf16_t, WS_LAT); bf16_t* H = WSP(bf16_t, WS_H); const bf16_t* OUTB = WSP(const bf16_t, WS_Z); const int* SLT = WSP(const int, WS_LIST) + (size_t)bid * WGSTR; const float* WTL = WSP(const float, WS_WT) + (size_t)bid * WGSTR;
                const float* mod = WSP(const float, WS_MOD) + (size_t)l * 33 * 6144;
                LAS f32x4* LNL = (LAS f32x4*)lds;
                for (int o = tid; o < 512; o += NT) LNL[o] = *(const f32x4*)((o < 256 ? P.in[I_LN2G] : P.in[I_LN2B]) + l * 1024 + (o & 255) * 4);
                LAS f32x4* G2L = (LAS f32x4*)(lds + 8192);
                for (int o = tid; o < 17 * 256; o += NT) { const int mrow = o >> 8; G2L[o] = *(const f32x4*)(mod + (size_t)(mrow == 16 ? 32 : g * GB + mrow) * 6144 + 5120 + (o & 255) * 4); }
                LAS f32x4* L1L = (LAS f32x4*)(lds + 8192 + 17 * 4096);
                for (int o = tid; o < 512; o += NT) L1L[o] = *(const f32x4*)((o < 256 ? P.in[I_LN1G] : P.in[I_LN1B]) + l * 1024 + (o & 255) * 4);
                __syncthreads();
                const float* modn = WSP(const float, WS_MOD) + (size_t)((l + 1) % DEPTH) * 33 * 6144;
                int nrows = 0; for (int r = bid * 8; r < TG; r += G * 8) nrows += (TG - r) < 8 ? (TG - r) : 8;
                REPS(14) {
                bf16_t* LATO = (DBG_REP == 14 && rep_ == 0) ? WSP(bf16_t, WS_GM) : LAT;
                for (int it = 0; it * 32 < nrows; ++it) {
                    int lane = tid & 63; asm volatile("" : "+v"(lane));
                    const int q = lane >> 4, l16 = lane & 15; const int lr = it * 32 + wid * 4 + q;
                    const int r = (lr >> 3) * (G * 8) + bid * 8 + (lr & 7);
                    const int bl = r / RPB, rr = r - bl * RPB, gb = g * GB + bl; const int mr = rr < CTX ? 32 : gb;
                    const bool ok = lr < nrows && r < TG && !(l == DEPTH - 1 && rr < CTX);
                    if (ok) {
                        const float* md = mod + (size_t)mr * 6144; bf16_t* lp = LAT + (size_t)r * 1024;
                        const int s0 = SLT[2 * lr], s1 = SLT[2 * lr + 1]; const float rw0 = WTL[2 * lr] * (1.0f / OUT_SCALE), rw1 = WTL[2 * lr + 1] * (1.0f / OUT_SCALE);
                        const unsigned char* o0 = (const unsigned char*)OUTB + (size_t)s0 * 1024; const unsigned char* o1 = (const unsigned char*)OUTB + (size_t)s1 * 1024;
                        f32x4 v[16]; float sm = 0.f;
                        unsigned a8[16], b8[16]; u32x2 lw[16];
#pragma unroll
                        for (int i = 0; i < 16; ++i) { const int c = i * 64 + l16 * 4; a8[i] = *(const unsigned*)(o0 + c); b8[i] = *(const unsigned*)(o1 + c); lw[i] = *(const u32x2*)(lp + c); }
                        asm volatile("" ::: "memory");
                        const int g2o = (rr < CTX ? 16 : bl) * 256 + l16;
                        float sa = 0.f;
#pragma unroll
                        for (int i = 0; i < 16; ++i) { v[i] = (f32x4){bf_lo(lw[i].x), bf_hi(lw[i].x), bf_lo(lw[i].y), bf_hi(lw[i].y)}; sa += (v[i][0] + v[i][1]) + (v[i][2] + v[i][3]); }
                        sa = row_sum16(sa); const float mean1 = sa * (1.0f / 1024.0f); float q1 = 0.f;
#pragma unroll
                        for (int i = 0; i < 16; ++i) { v[i] = v[i] - mean1; q1 += (v[i][0] * v[i][0] + v[i][1] * v[i][1]) + (v[i][2] * v[i][2] + v[i][3] * v[i][3]); }
                        q1 = row_sum16(q1); const float rstd1 = 1.0f / sqrtf(q1 * (1.0f / 1024.0f) + LN_EPS);
#pragma unroll
                        for (int i = 0; i < 16; ++i) { const f32x4 a = fp8x4_f32(a8[i]), b = fp8x4_f32(b8[i]);
                            const f32x4 f = rw0 * a + rw1 * b;
                            const f32x4 lv = v[i] * rstd1 * L1L[i * 16 + l16] + L1L[256 + i * 16 + l16];
                            v[i] = ALPHA * lv + (DBG_NOMOE ? 0.f : 1.f) * G2L[g2o + i * 16] * f; sm += (v[i][0] + v[i][1]) + (v[i][2] + v[i][3]); }
                        sm = row_sum16(sm); const float mean = sm * (1.0f / 1024.0f); float qv = 0.f;
#pragma unroll
                        for (int i = 0; i < 16; ++i) { v[i] = v[i] - mean; qv += (v[i][0] * v[i][0] + v[i][1] * v[i][1]) + (v[i][2] * v[i][2] + v[i][3] * v[i][3]); }
                        qv = row_sum16(qv); const float rstd = 1.0f / sqrtf(qv * (1.0f / 1024.0f) + LN_EPS);
                        if (l == DEPTH - 1) {
#pragma unroll
                            for (int i = 0; i < 16; ++i) { const int c = i * 64 + l16 * 4;
                                const f32x4 o = v[i] * rstd * LNL[i * 16 + l16] + LNL[256 + i * 16 + l16];
                                *(f32x4*)(P.out + ((size_t)gb * SEQ + (rr - CTX)) * 1024 + c) = o; }
                        } else {
                            const float* mn = modn + (size_t)mr * 6144 + l16 * 4; f32x4 pc[2], ps[2];
#pragma unroll
                            for (int i = 0; i < 2; ++i) { ps[i] = *(const f32x4*)(mn + i * 64); pc[i] = *(const f32x4*)(mn + 1024 + i * 64); }
#pragma unroll
                            for (int i = 0; i < 16; ++i) { const int c = i * 64 + l16 * 4;
                                const f32x4 o = v[i] * rstd * LNL[i * 16 + l16] + LNL[256 + i * 16 + l16];
                                { u32x2 wl; wl.x = cvt_pk_bf16(o[0], o[1]); wl.y = cvt_pk_bf16(o[2], o[3]); *(u32x2*)(LATO + (size_t)r * 1024 + c) = wl; }
                                const f32x4 mdn_sh = ps[i & 1], mdn_sc = pc[i & 1];
                                if (i + 2 < 16) { ps[i & 1] = *(const f32x4*)(mn + (i + 2) * 64); pc[i & 1] = *(const f32x4*)(mn + 1024 + (i + 2) * 64); }
                                const f32x4 h = o * (1.0f + mdn_sc) + mdn_sh; *(unsigned*)((unsigned char*)H + (size_t)r * 1024 + c) = cvt_pk4_fp8(h[0], h[1], h[2], h[3]);
                                asm volatile("" ::: "memory"); }
                        }
                    }
                }
                }
            }
            { PHASE_IDS(); (void)ws; xcd_barrier(bar, tid); }
        }
    }
    { PHASE_IDS(); if (bid == 0 && tid == 0 && xb_ld(WSP(unsigned, WS_CTL) + CW_BAR + XB_TMO) != 0u) P.out[0] = __builtin_nanf(""); }
#undef PHASE_IDS
#undef WSP
}

constexpr int LDS_BYTES = 131072 + 1024;
extern "C" void kernel_launch(void* const* d_in, const int* in_sizes, int n_in, void* d_out, int out_size, void* d_ws, size_t ws_size, hipStream_t stream) {
    static int grid = 0;
    if (grid == 0) {
        if (n_in != 28 || out_size != NB * SEQ * DM || ws_size < WS_END) { fprintf(stderr, "kernel_launch: unexpected problem (n_in %d, out %d, ws %zu < %zu)\n", n_in, out_size, ws_size, (size_t)WS_END); grid = -1; return; }
        int dev = 0, cus = 0;
        if (hipGetDevice(&dev) != hipSuccess || hipDeviceGetAttribute(&cus, hipDeviceAttributeMultiprocessorCount, dev) != hipSuccess) { grid = -1; return; }
        if (hipFuncSetAttribute((const void*)mk_fwd, hipFuncAttributeMaxDynamicSharedMemorySize, LDS_BYTES) != hipSuccess) { fprintf(stderr, "kernel_launch: hipFuncSetAttribute failed\n"); grid = -1; return; }
        int per_cu = 0;
        if (hipOccupancyMaxActiveBlocksPerMultiprocessor(&per_cu, (const void*)mk_fwd, NT, LDS_BYTES) != hipSuccess || per_cu < 1) fprintf(stderr, "kernel_launch: occupancy query says %d\n", per_cu);
        (void)hipGetLastError();
        grid = cus;
    }
    if (grid < 0) return;
    if (hipMemsetAsync((char*)d_ws + WS_CTL, 0, CTL_BYTES, stream) != hipSuccess) return;
    Params p{};
    for (int i = 0; i < 28; ++i) p.in[i] = (const float*)d_in[i];
    p.out = (float*)d_out; p.ws = (unsigned char*)d_ws;
    hipLaunchKernelGGL(mk_fwd, dim3(grid), dim3(NT), LDS_BYTES, stream, p);
}
```

```cpp
#include <hip/hip_runtime.h>
#include <cstdio>
#include <cstdint>
#include <cstddef>

#define LAS __attribute__((address_space(3)))
#define GAS __attribute__((address_space(1)))
typedef unsigned short bf16_t;
typedef short bf16x8 __attribute__((ext_vector_type(8)));
typedef short s16x4 __attribute__((ext_vector_type(4)));
typedef float f32x2 __attribute__((ext_vector_type(2)));
typedef float f32x4 __attribute__((ext_vector_type(4)));
typedef float f32x16 __attribute__((ext_vector_type(16)));
typedef unsigned u32x2 __attribute__((ext_vector_type(2)));
typedef unsigned u32x4 __attribute__((ext_vector_type(4)));

constexpr int DM = 1024, NB = 32, SEQ = 2048, DEPTH = 2, CTX = 256, RPB = CTX + SEQ;
constexpr int NH = 8, QLORA = 384, KVLORA = 256, NE = 16, DE = 512;
constexpr int OFF_Q = 2048, OFF_KV = 2432, OFF_KR = 2688, OFF_G = 2752, IN_COLS = 4800;
constexpr int NIN = 4864;
constexpr int NMID = 768;
constexpr float LN_EPS = 1e-5f, ALPHA = 1.4142135623730951f;
constexpr int NG = 2, GB = NB / NG, TG = GB * RPB, NPAN = TG / 256;
#ifndef DBG_STOP
#define DBG_STOP 0
#endif
#ifndef DBG_FILL
#define DBG_FILL 0
#endif
#ifndef DBG_NOMOE
#define DBG_NOMOE 0
#endif
#ifndef DBG_NOMIX
#define DBG_NOMIX 0
#endif
#ifndef DBG_GM
#define DBG_GM 0
#endif
#ifndef DBG_NOGMB
#define DBG_NOGMB 0
#endif
#ifndef DBG_GA1
#define DBG_GA1 0
#endif
#ifndef DBG_COL0
#define DBG_COL0 0
#endif
#ifndef DBG_SEL
#define DBG_SEL 0
#endif
#ifndef DBG_REP
#define DBG_REP 100
#endif
#define REPS(k) for (int rep_ = 0; rep_ < ((DBG_REP == (k)) ? 2 : 1); ++rep_)
#ifndef DBG_EPI2
#define DBG_EPI2 0
#endif
#ifndef DBG_K2
#define DBG_K2 0
#endif
#ifndef DBG_NOATT
#define DBG_NOATT 0
#endif
#ifndef DBG_MIXSCALE
#define DBG_MIXSCALE 1.0f
#endif
constexpr int NT = 512;
constexpr int WGSTR = 320;
#ifndef MK_MASK
#define MK_MASK 0xFFFFu
#endif
#define PH(k) ((MK_MASK >> (k)) & 1u)

constexpr size_t al256(size_t x) { return (x + 255) / 256 * 256; }
constexpr size_t WS_CTL  = 0;
constexpr size_t CTL_BYTES = 65536;
constexpr size_t WS_MOD  = WS_CTL + CTL_BYTES;
constexpr size_t WS_ROPE = WS_MOD + al256((size_t)2 * 33 * 6144 * 4);
constexpr size_t WS_WIN  = WS_ROPE + (size_t)2 * 2048 * 32 * 4;
constexpr size_t WS_WUQ  = WS_WIN + (size_t)2 * NIN * 1024 * 2;
constexpr size_t WS_WUKV = WS_WUQ + (size_t)2 * 1536 * 384 * 2;
constexpr size_t WS_WPA  = WS_WUKV + (size_t)2 * 2048 * 256 * 2;
constexpr size_t WS_WPB  = WS_WPA + (size_t)2 * 1024 * 1024 * 2;
constexpr size_t WS_WO   = WS_WPB + (size_t)2 * 1024 * 1024 * 2;
constexpr size_t WS_WGU  = WS_WO + (size_t)2 * 1024 * 1024 * 2;
constexpr size_t WS_WD   = WS_WGU + (size_t)2 * 16 * 1024 * 1024 * 2;
constexpr size_t WS_WS   = WS_WD + (size_t)2 * 16 * 1024 * 512 * 2;
constexpr size_t WS_LIST = WS_WS + (size_t)2 * 8 * 128 * 128 * 2;
constexpr size_t WS_WT   = WS_LIST + (size_t)16 * TG * 4;
constexpr size_t WS_LAT  = WS_WT + (size_t)1048576;
constexpr size_t WS_H    = WS_LAT + (size_t)TG * 1024 * 2;
constexpr size_t WS_Z    = WS_H + (size_t)TG * 1024 * 2;
constexpr size_t WS_GT   = WS_Z + (size_t)TG * 2048 * 2;
constexpr size_t WS_MID  = WS_GT + (size_t)TG * 2048 * 2;
constexpr size_t WS_KV   = WS_MID + (size_t)TG * NMID * 4;
constexpr size_t WS_GM   = WS_KV + (size_t)TG * 2048 * 2;
constexpr size_t WS_END  = WS_GM + (size_t)TG * 1024 * 2;
constexpr size_t WS_QN   = WS_H;
constexpr size_t WS_KVN  = WS_QN + (size_t)TG * 512;
constexpr size_t WS_KR   = WS_KVN + (size_t)TG * 256;
static_assert(WS_KR + (size_t)TG * 64 * 2 <= WS_Z, "alias overflow");
static_assert(TG % 32 == 0, "P2a works on 32-row blocks");
static_assert(NPAN % 8 == 0 && (GB * 8) % 8 == 0, "DenseOrder assumes whole groups of 8 row panels");
constexpr int CW_BAR = 0;
constexpr int CW_CNT = 4096;

#define XB_TMO      128
#define XB_XCNT(j)  (256  + 64 * (j))
#define XB_XSUB(j)  (1280 + 64 * (j))
#define XB_XGEN(j)  (2304 + 64 * (j))
#define XB_TOP      3328
#define XB_TOPGEN   3392
#define XCD_BAR_WORDS 3456
#define XB_SPIN_CAP (1u << 23)
__device__ __forceinline__ unsigned xb_ld(unsigned* p)              { return __hip_atomic_load(p, __ATOMIC_RELAXED, __HIP_MEMORY_SCOPE_AGENT); }
__device__ __forceinline__ unsigned xb_add(unsigned* p, unsigned v) { return __hip_atomic_fetch_add(p, v, __ATOMIC_RELAXED, __HIP_MEMORY_SCOPE_AGENT); }
__device__ __forceinline__ unsigned xb_xcc_id() { return (unsigned)__builtin_amdgcn_s_getreg((3 << 11) | 20) & 0xFu; }
#define XB_SPIN(cond, bar) do { unsigned _sp = 0; while (cond) { __builtin_amdgcn_s_sleep(1); \
    if ((++_sp & 255u) == 0u) { if (xb_ld(&(bar)[XB_TMO])) break; if (_sp > XB_SPIN_CAP) { atomicAdd(&(bar)[XB_TMO], 1u); break; } } } } while (0)
struct XcdBarrier { unsigned* bar; unsigned x; volatile LAS unsigned* st; };
__device__ __forceinline__ XcdBarrier xcd_barrier_post(unsigned* bar, volatile LAS unsigned* st) {
    XcdBarrier b; b.bar = bar; b.x = xb_xcc_id(); b.st = st;
    if (threadIdx.x == 0) (void)xb_add(&bar[XB_XCNT(b.x)], 1u);
    return b;
}
__device__ __forceinline__ void xcd_barrier_complete(unsigned* bar, unsigned x, unsigned& nloc, unsigned& nx) {
    const unsigned G = gridDim.x * gridDim.y * gridDim.z;
    unsigned sum, cnt, mine, sp = 0u;
    for (;;) {
        sum = 0u; cnt = 0u; mine = 0u;
#pragma unroll
        for (unsigned j = 0; j < 16; ++j) { const unsigned c = xb_ld(&bar[XB_XCNT(j)]); sum += c; cnt += (c > 0u) ? 1u : 0u; mine = (j == x) ? c : mine; }
        if (sum == G) break;
        __builtin_amdgcn_s_sleep(1);
        if ((++sp & 255u) == 0u) { if (xb_ld(&bar[XB_TMO])) break; if (sp > XB_SPIN_CAP) { atomicAdd(&bar[XB_TMO], 1u); break; } }
    }
    nloc = mine > 0u ? mine : 1u; nx = cnt > 0u ? cnt : 1u;
}
__device__ __forceinline__ void xcd_barrier(const XcdBarrier& b, int tid0) {
    asm volatile("s_waitcnt vmcnt(0)" ::: "memory");
    __syncthreads();
    if (tid0 == 0) {
        GAS unsigned* barg_ = (GAS unsigned*)b.bar; unsigned bx = b.x;
        asm volatile("" : "+s"(barg_), "+s"(bx));
        unsigned* bar = (unsigned*)barg_;
        __builtin_amdgcn_s_waitcnt(0);
        unsigned nloc = b.st[0], nx = b.st[1];
        if (nloc == 0u) { xcd_barrier_complete(bar, bx, nloc, nx); b.st[0] = nloc; b.st[1] = nx; }
        const unsigned old = xb_add(&bar[XB_XSUB(bx)], 1u);
        const unsigned gen = old / nloc;
        if (old + 1u == (gen + 1u) * nloc) {
            __builtin_amdgcn_fence(__ATOMIC_RELEASE, "agent");
            asm volatile("s_waitcnt vmcnt(0)" ::: "memory");
            const unsigned og = xb_add(&bar[XB_TOP], 1u);
            const unsigned tg = og / nx;
            if (og + 1u == (tg + 1u) * nx) xb_add(&bar[XB_TOPGEN], 1u);
            else XB_SPIN(xb_ld(&bar[XB_TOPGEN]) == tg, bar);
            __builtin_amdgcn_fence(__ATOMIC_ACQUIRE, "agent");
            xb_add(&bar[XB_XGEN(bx)], 1u);
            asm volatile("s_waitcnt vmcnt(0)" ::: "memory");
        } else {
            XB_SPIN(xb_ld(&bar[XB_XGEN(bx)]) == gen, bar);
            __builtin_amdgcn_fence(__ATOMIC_ACQUIRE, "agent");
            asm volatile("s_waitcnt vmcnt(0)" ::: "memory");
        }
    }
    __syncthreads();
}

typedef __bf16 bf16x2_t __attribute__((ext_vector_type(2)));
__device__ __forceinline__ unsigned cvt_pk_bf16(float lo, float hi) { f32x2 v = {lo, hi}; bf16x2_t r = __builtin_convertvector(v, bf16x2_t); return __builtin_bit_cast(unsigned, r); }
__device__ __forceinline__ unsigned cvt_pk4_fp8(float a, float b, float c, float d) { int w = 0; w = __builtin_amdgcn_cvt_pk_fp8_f32(a, b, w, false); w = __builtin_amdgcn_cvt_pk_fp8_f32(c, d, w, true); return (unsigned)w; }
__device__ __forceinline__ f32x4 fp8x4_f32(unsigned w) { const f32x2 a = __builtin_amdgcn_cvt_pk_f32_fp8((int)w, false), b = __builtin_amdgcn_cvt_pk_f32_fp8((int)w, true); return (f32x4){a[0], a[1], b[0], b[1]}; }
__device__ __forceinline__ bf16_t f2bf(float f) { return (bf16_t)(cvt_pk_bf16(f, 0.f) & 0xffffu); }
__device__ __forceinline__ float bf_lo(unsigned w) { return __uint_as_float(w << 16); }
__device__ __forceinline__ float bf_hi(unsigned w) { return __uint_as_float(w & 0xffff0000u); }
__device__ __forceinline__ float fsigmoid(float x) { return __builtin_amdgcn_rcpf(1.0f + __builtin_amdgcn_exp2f(-1.4426950408889634f * x)); }
__device__ __forceinline__ float gelu_tanh(float x) { const float u = 1.5957691216057308f * (x + 0.044715f * x * x * x); return x * fsigmoid(u); }
__device__ __forceinline__ f32x4 gelu4_a32(f32x4 a) { const f32x4 t = a * a; const f32x4 p = t * (-3.14157838e-6f) + (-0.0719440062f); const f32x4 arg = a * p; f32x4 e;
#pragma unroll
    for (int j = 0; j < 4; ++j) e[j] = __builtin_amdgcn_exp2f(arg[j]);
    const f32x4 d = e * 32.0f + 32.0f; f32x4 r;
#pragma unroll
    for (int j = 0; j < 4; ++j) r[j] = __builtin_amdgcn_rcpf(d[j]);
    return a * r; }
__device__ __forceinline__ f32x4 sigmoid4_a32(f32x4 a, f32x4 nb) { const f32x4 arg = a * (-0.0450842200f) + nb; f32x4 r;
#pragma unroll
    for (int j = 0; j < 4; ++j) r[j] = __builtin_amdgcn_rcpf(1.0f + __builtin_amdgcn_exp2f(arg[j]));
    return r; }
template <int N> __device__ __forceinline__ float row_ror(float x) { return __uint_as_float((unsigned)__builtin_amdgcn_update_dpp(0, (int)__float_as_uint(x), 0x120 + N, 0xf, 0xf, false)); }
__device__ __forceinline__ float row_sum16(float x) { x += row_ror<8>(x); x += row_ror<4>(x); x += row_ror<2>(x); x += row_ror<1>(x); return x; }
__device__ __forceinline__ float wave_sum(float x) { x = row_sum16(x);
    { auto r = __builtin_amdgcn_permlane16_swap(__float_as_uint(x), __float_as_uint(x), false, false); x = __uint_as_float(r[0]) + __uint_as_float(r[1]); }
    { auto r = __builtin_amdgcn_permlane32_swap(__float_as_uint(x), __float_as_uint(x), false, false); x = __uint_as_float(r[0]) + __uint_as_float(r[1]); }
    return x; }
__device__ __forceinline__ void reduce16_rows(const float (&x)[16], float (&z)[4]) {
    float y[8];
#pragma unroll
    for (int k = 0; k < 8; ++k) { auto r = __builtin_amdgcn_permlane32_swap(__float_as_uint(x[k]), __float_as_uint(x[k + 8]), false, false); y[k] = __uint_as_float(r[0]) + __uint_as_float(r[1]); }
#pragma unroll
    for (int k = 0; k < 4; ++k) { auto r = __builtin_amdgcn_permlane16_swap(__float_as_uint(y[k]), __float_as_uint(y[k + 4]), false, false); z[k] = row_sum16(__uint_as_float(r[0]) + __uint_as_float(r[1])); }
}
__device__ __forceinline__ float bcast_entry(const float (&z)[4], int e) { return __uint_as_float((unsigned)__builtin_amdgcn_readlane((int)__float_as_uint(z[e & 3]), (e >> 2) * 16)); }
__host__ __device__ __forceinline__ int rope_orig(int p) { const int b = p >> 3, j = p & 7; return (j < 4) ? (4 * b + j) : (32 + 4 * b + (j - 4)); }

struct Params { const float* in[28]; float* out; unsigned char* ws; };
enum { I_X = 0, I_C, I_CTX, I_CCTX, I_WADA, I_BADA, I_WIN, I_GMLNG, I_GMLNB, I_GMWS, I_GMBS, I_QNORM, I_WUQ, I_KVNORM, I_WUKV, I_WPA, I_WPB, I_BMERGE, I_WOUT,
       I_LN1G, I_LN1B, I_WROUTER, I_BROUTER, I_WEG, I_WEU, I_WED, I_LN2G, I_LN2B };

__device__ __forceinline__ int row_mod(int r, int g) { const int bl = r / RPB, rr = r - bl * RPB; return rr < CTX ? 32 : g * GB + bl; }

namespace pg8 {
constexpr int BM = 256, BK = 64, HALF = 128, HTB = HALF * BK * 2, STAGE_BYTES = 8 * HTB, NXCD = 8, WGM = 8;
__host__ __device__ __forceinline__ int lds_byte(int r, int c) { const int st = (r >> 4) * 2 + (c >> 5), rr = r & 15, cc = c & 31, ob = rr * 64 + cc * 2; return st * 1024 + (ob ^ (((ob >> 9) & 1) << 5)); }
__host__ __device__ __forceinline__ void stage_rc(int b, int& R, int& C) { const int st = b / 1024, sb = b % 1024, swz = sb ^ (((sb >> 9) & 1) << 5); R = (st >> 1) * 16 + swz / 64; C = (st & 1) * 32 + (swz % 64) / 2; }
__host__ __device__ __forceinline__ int perm32(int rho) { const int n = rho >> 4, i = rho & 15; return 8 * (i >> 2) + 4 * n + (i & 3); }

struct Unit { int pm, pn, bt, aux; };
struct Gemm { const unsigned char* A; const bf16_t* Bt; int K; };

struct DenseOrder {
    static constexpr bool GATHER = false;
    int nM, nN, nwg, G, c, latmap, ext_n, ext_pn0, ntot; float rnig;
    __device__ void init(int nM_, int nN_, int G_, int c_, int latmap_ = 0, int ext_n_ = 0, int ext_pn0_ = 0) { nM = nM_; nN = nN_; nwg = nM * nN; G = G_; c = c_; latmap = latmap_; ext_n = ext_n_; ext_pn0 = ext_pn0_; ntot = nwg + GB * ext_n; rnig = 1.0f / (float)(WGM * nN); }
    __device__ __forceinline__ bool next(int i, Unit& u) const {
        const long L = (long)i * G + c; if (L >= ntot) return false;
        u.aux = 0;
        if (L >= nwg) { const int idx = (int)L - nwg; u.pm = (idx / ext_n) * 9; u.pn = ext_pn0 + idx % ext_n; u.bt = u.pn; return true; }
        int wgid = (int)L; { const int q = nwg / NXCD, r = nwg % NXCD, xcd = wgid % NXCD, off = wgid / NXCD; wgid = (xcd < r ? xcd * (q + 1) : r * (q + 1) + (xcd - r) * q) + off; }
        const int nig = WGM * nN, gid = (int)(((float)wgid + 0.5f) * rnig), within = wgid - gid * nig;
        int pm = gid * WGM + (within & (WGM - 1)); if (latmap) pm = (pm >> 3) * 9 + 1 + (pm & 7);
        u.pm = pm; u.pn = within >> 3; u.bt = u.pn; return true;
    }
    __device__ __forceinline__ unsigned arow(const Unit& u, int r) const { return (unsigned)(u.pm * BM + r); }
};

typedef int i32x8 __attribute__((ext_vector_type(8)));
template <class Epi, class Sched, bool FP8 = false>
__device__ __forceinline__ void gemm_phase(LAS unsigned char* lds, const Gemm g, const Sched& S, const Epi& E, int tid_in) {
    constexpr bool GA = Sched::GATHER;
    int tid = tid_in; asm volatile("" : "+v"(tid));
    const int wid = __builtin_amdgcn_readfirstlane(tid >> 6), lane = tid & 63, wr = wid >> 2, wc = wid & 3, fr = lane & 15, fq = lane >> 4;
    int K = g.K; asm volatile("" : "+s"(K));
    const int nt = K / BK;
    const unsigned rowB = (unsigned)K * 2u;
    unsigned voffA0, voffA1, voffB0, voffB1;
    { int R, C; stage_rc(tid * 16, R, C); voffA0 = (unsigned)(R * K + C) * 2u; voffB0 = (unsigned)(((R & ~31) + perm32(R & 31)) * K + C) * 2u;
      stage_rc(tid * 16 + 8192, R, C); voffA1 = (unsigned)(R * K + C) * 2u; voffB1 = (unsigned)(((R & ~31) + perm32(R & 31)) * K + C) * 2u; }
    const size_t kstep = (size_t)(BK * 2);
    const size_t hstep = (size_t)HALF * K * 2;
    const size_t tstep = 2 * hstep;
    const unsigned ldsw = (unsigned)wid * 1024u;
    const int aoff = lds_byte(wr * 64 + fr, fq * 8), boff = lds_byte(wc * 32 + fr, fq * 8);
#define PG8_SA(b, h) (((b) * 2 + (h)) * HTB)
#define PG8_SB(b, h) ((4 + (b) * 2 + (h)) * HTB)
#define PG8_STAGE(bufoff, gbase, v0, v1) do { \
        __builtin_amdgcn_global_load_lds((const unsigned*)((const char*)(gbase) + (v0)), (LAS unsigned*)(lds + (bufoff) + ldsw), 16, 0, 0); \
        __builtin_amdgcn_global_load_lds((const unsigned*)((const char*)(gbase) + (v1)), (LAS unsigned*)(lds + (bufoff) + ldsw + 8192), 16, 0, 0); } while (0)
#define PG8_STAGE_A(bufoff, ptr, h) do { if constexpr (GA) { PG8_STAGE(bufoff, ptr, (h) ? c10 : c00, (h) ? c11 : c01); } else { PG8_STAGE(bufoff, (ptr) + ((h) ? hstep : (size_t)0), voffA0, voffA1); } } while (0)
#define PG8_LD8(dst, idx, addr) do { const u32x4 lo_ = *(const LAS u32x4*)(addr), hi_ = *(const LAS u32x4*)((addr) + 1024); dst[idx] = (i32x8){(int)lo_.x, (int)lo_.y, (int)lo_.z, (int)lo_.w, (int)hi_.x, (int)hi_.y, (int)hi_.z, (int)hi_.w}; } while (0)
#define PG8_LDA(dst, b, h) do { _Pragma("unroll") for (int m = 0; m < 4; ++m) PG8_LD8(dst, m, lds + PG8_SA(b, h) + aoff + m * 2048); } while (0)
#define PG8_LDB(dst, b, h) do { _Pragma("unroll") for (int n = 0; n < 2; ++n) PG8_LD8(dst, n, lds + PG8_SB(b, h) + boff + n * 2048); } while (0)
#define PG8_HALF(v, k) __builtin_bit_cast(bf16x8, (k) ? __builtin_shufflevector(v, v, 4, 5, 6, 7) : __builtin_shufflevector(v, v, 0, 1, 2, 3))
#define PG8_MMA(ai, bj, At, Bt) do { __builtin_amdgcn_s_setprio(1); _Pragma("unroll") for (int m = 0; m < 4; ++m) _Pragma("unroll") for (int n = 0; n < 2; ++n) { \
        if constexpr (FP8) asm volatile("v_mfma_scale_f32_16x16x128_f8f6f4 %0, %1, %2, %0, %3, %3 op_sel_hi:[0,0,0]" : "+v"(acc[ai][bj][m][n]) : "v"(Bt[n]), "v"(At[m]), "v"(one_scale));   \
        else { acc[ai][bj][m][n] = __builtin_amdgcn_mfma_f32_16x16x32_bf16(PG8_HALF(Bt[n], 0), PG8_HALF(At[m], 0), acc[ai][bj][m][n], 0, 0, 0); \
               acc[ai][bj][m][n] = __builtin_amdgcn_mfma_f32_16x16x32_bf16(PG8_HALF(Bt[n], 1), PG8_HALF(At[m], 1), acc[ai][bj][m][n], 0, 0, 0); } } \
        __builtin_amdgcn_s_setprio(0); } while (0)
#define PG8_ZERO(ai, bj) do { if (t == 0) { _Pragma("unroll") for (int m = 0; m < 4; ++m) _Pragma("unroll") for (int n = 0; n < 2; ++n) acc[ai][bj][m][n] = (f32x4){0.f, 0.f, 0.f, 0.f}; } } while (0)
#define PG8_WAIT_V(n) asm volatile("s_waitcnt vmcnt(" #n ")" ::: "memory")
#define PG8_WAIT_L(n) asm volatile("s_waitcnt lgkmcnt(" #n ")" ::: "memory")
#define PG8_BAR __builtin_amdgcn_s_barrier()
#define PG8_SCHED __builtin_amdgcn_sched_barrier(0)
#define PG8_AOFF(d00, d01, d10, d11, u) do { int _R0, _C0, _R1, _C1; stage_rc(tid * 16, _R0, _C0); stage_rc(tid * 16 + 8192, _R1, _C1); \
        d00 = S.arow(u, _R0) * rowB + (unsigned)_C0 * 2u; d01 = S.arow(u, _R1) * rowB + (unsigned)_C1 * 2u; \
        d10 = S.arow(u, HALF + _R0) * rowB + (unsigned)_C0 * 2u; d11 = S.arow(u, HALF + _R1) * rowB + (unsigned)_C1 * 2u; } while (0)
    Unit cur, nxt; int ui = 0;
    if (!S.next(0, cur)) return;
    f32x4 acc[2][2][4][2];
    i32x8 At[4], B0[2], B1[2];
    int one_scale = 0x7f7f7f7f; asm volatile("" : "+v"(one_scale));
    unsigned c00 = 0, c01 = 0, c10 = 0, c11 = 0, n00 = 0, n01 = 0, n10 = 0, n11 = 0;
    if constexpr (GA) PG8_AOFF(c00, c01, c10, c11, cur);
    const char* cA = (const char*)g.A + (GA ? (size_t)0 : (size_t)S.arow(cur, 0) * rowB); const char* cB = (const char*)g.Bt + (size_t)cur.bt * tstep;
    PG8_STAGE(PG8_SB(0, 0), cB, voffB0, voffB1); PG8_STAGE_A(PG8_SA(0, 0), cA, 0); PG8_STAGE(PG8_SB(0, 1), cB + hstep, voffB0, voffB1); PG8_STAGE_A(PG8_SA(0, 1), cA, 1);
    if (wr == 1) PG8_BAR;
    PG8_WAIT_V(4); PG8_BAR;
    PG8_STAGE(PG8_SB(1, 0), cB + kstep, voffB0, voffB1); PG8_STAGE_A(PG8_SA(1, 0), cA + kstep, 0); PG8_STAGE(PG8_SB(1, 1), cB + hstep + kstep, voffB0, voffB1);
    PG8_WAIT_V(6); PG8_BAR;
    for (;;) {
        const bool has_next = S.next(DBG_K2 ? (ui + 1) >> 1 : ui + 1, nxt);
        if constexpr (GA) { if (has_next) { PG8_AOFF(n00, n01, n10, n11, nxt); } else { n00 = c00; n01 = c01; n10 = c10; n11 = c11; } }
        const char* nA = (GA || !has_next) ? cA : (const char*)g.A + (size_t)S.arow(nxt, 0) * rowB;
        const char* nB = has_next ? (const char*)g.Bt + (size_t)nxt.bt * tstep : cB;
        for (int t = 0; t < nt; t += 2) {
            const bool last = (t == nt - 2);
            const char* a1 = cA + (size_t)(t + 1) * kstep;
            const char* a2 = last ? nA : cA + (size_t)(t + 2) * kstep; const char* b2 = last ? nB : cB + (size_t)(t + 2) * kstep;
            const char* a3 = a2 + kstep; const char* b3 = b2 + kstep;
            PG8_LDB(B0, 0, 0); PG8_SCHED; PG8_LDA(At, 0, 0); PG8_STAGE_A(PG8_SA(1, 1), a1, 1);
            if constexpr (GA) { if (last) { c00 = n00; c01 = n01; c10 = n10; c11 = n11; } }
            PG8_WAIT_L(0); PG8_BAR; PG8_ZERO(0, 0); PG8_MMA(0, 0, At, B0); PG8_BAR; PG8_SCHED;
            PG8_LDB(B1, 0, 1); PG8_STAGE(PG8_SB(0, 0), b2, voffB0, voffB1);
            PG8_WAIT_L(0); PG8_BAR; PG8_ZERO(0, 1); PG8_MMA(0, 1, At, B1); PG8_BAR;
            PG8_LDA(At, 0, 1); PG8_STAGE_A(PG8_SA(0, 0), a2, 0);
            PG8_WAIT_L(0); PG8_BAR; PG8_ZERO(1, 0); PG8_MMA(1, 0, At, B0); PG8_BAR; PG8_SCHED;
            PG8_STAGE(PG8_SB(0, 1), b2 + hstep, voffB0, voffB1);
            PG8_WAIT_V(6); PG8_BAR; PG8_ZERO(1, 1); PG8_MMA(1, 1, At, B1); PG8_BAR;
            PG8_LDB(B0, 1, 0); PG8_SCHED; PG8_LDA(At, 1, 0); PG8_STAGE_A(PG8_SA(0, 1), a2, 1);
            PG8_WAIT_L(0); PG8_BAR; PG8_MMA(0, 0, At, B0); PG8_BAR; PG8_SCHED;
            PG8_LDB(B1, 1, 1); PG8_STAGE(PG8_SB(1, 0), b3, voffB0, voffB1);
            PG8_WAIT_L(0); PG8_BAR; PG8_MMA(0, 1, At, B1); PG8_BAR;
            PG8_LDA(At, 1, 1); PG8_STAGE_A(PG8_SA(1, 0), a3, 0);
            PG8_WAIT_L(0); PG8_BAR; PG8_MMA(1, 0, At, B0); PG8_BAR; PG8_SCHED;
            PG8_STAGE(PG8_SB(1, 1), b3 + hstep, voffB0, voffB1);
            PG8_WAIT_V(6); PG8_BAR; PG8_MMA(1, 1, At, B1); PG8_BAR;
        }
        if constexpr (FP8) asm volatile("s_nop 15\n\ts_nop 15\n\ts_nop 15\n\ts_nop 15" ::: "memory");
        if (!DBG_K2 || (ui & 1)) E(acc, cur, wr, wc, fr, fq);
        if constexpr (DBG_EPI2 != 0 && Epi::IDEM) {
#pragma unroll
            for (int a = 0; a < 2; ++a)
#pragma unroll
                for (int b = 0; b < 2; ++b)
#pragma unroll
                    for (int m = 0; m < 4; ++m)
#pragma unroll
                        for (int n = 0; n < 2; ++n) asm volatile("" : "+v"(acc[a][b][m][n]));
            E(acc, cur, wr, wc, fr, fq); }
        if (!has_next) break;
        cur = nxt; cA = nA; cB = nB; ++ui;
    }
    PG8_WAIT_V(0);
    if (wr == 0) PG8_BAR;
    PG8_BAR;
#undef PG8_SA
#undef PG8_SB
#undef PG8_STAGE
#undef PG8_STAGE_A
#undef PG8_LDA
#undef PG8_LDB
#undef PG8_LD8
#undef PG8_HALF
#undef PG8_MMA
#undef PG8_ZERO
#undef PG8_WAIT_V
#undef PG8_WAIT_L
#undef PG8_BAR
#undef PG8_SCHED
#undef PG8_AOFF
}
}
using pg8::Unit; using pg8::Gemm; using pg8::DenseOrder;
typedef const f32x4 (&AccRef)[2][2][4][2];

__device__ __forceinline__ void st_bf16x8(bf16_t* p, f32x4 v0, f32x4 v1) {
    u32x4 w; w.x = cvt_pk_bf16(v0[0], v0[1]); w.y = cvt_pk_bf16(v0[2], v0[3]); w.z = cvt_pk_bf16(v1[0], v1[1]); w.w = cvt_pk_bf16(v1[2], v1[3]); *(u32x4*)p = w; }

constexpr float WU_SCALE = 16.0f;
constexpr float OUT_SCALE = 8.0f;
constexpr float WO_SCALE = 64.0f, ATT_SCALE = 32.0f;
constexpr float WIN_SCALE = 32.0f;
static_assert(WIN_SCALE == 32.0f, "gelu4_a32 / sigmoid4_a32 / the gate-up epilogue fold this scale into their constants");
struct EpiIn {
    static constexpr bool IDEM = true;
    bf16_t* Z; float* MID; bf16_t* GT; const float* bmerge;
    __device__ __forceinline__ void operator()(AccRef acc, const Unit& u, int wr, int wc, int fr, int fq) const {
        const int row0 = u.pm * 256 + wr * 64 + fr, cb = wc * 32 + 8 * fq;
        if (u.pn < 8) {
#pragma unroll
            for (int ai = 0; ai < 2; ++ai)
#pragma unroll
                for (int m = 0; m < 4; ++m) { unsigned char* rp = (unsigned char*)Z + (size_t)(row0 + ai * 128 + m * 16) * 2048 + u.pn * 256 + cb;
#pragma unroll
                    for (int bj = 0; bj < 2; ++bj) { const f32x4 v0 = gelu4_a32(acc[ai][bj][m][0]), v1 = gelu4_a32(acc[ai][bj][m][1]);
                        u32x2 w; w.x = cvt_pk4_fp8(v0[0], v0[1], v0[2], v0[3]); w.y = cvt_pk4_fp8(v1[0], v1[1], v1[2], v1[3]); *(u32x2*)(rp + bj * 128) = w; } }
        } else if (u.pn < 11) {
#pragma unroll
            for (int ai = 0; ai < 2; ++ai)
#pragma unroll
                for (int m = 0; m < 4; ++m) { bf16_t* rp = (bf16_t*)MID + (size_t)(row0 + ai * 128 + m * 16) * NMID + (u.pn - 8) * 256 + cb;
#pragma unroll
                    for (int bj = 0; bj < 2; ++bj) st_bf16x8(rp + bj * 128, acc[ai][bj][m][0] * (1.0f / WIN_SCALE), acc[ai][bj][m][1] * (1.0f / WIN_SCALE)); }
        } else if (DBG_STOP != 24) {
            const int c0 = (u.pn - 11) * 256 + cb;
            f32x4 bv[2][2];
#pragma unroll
            for (int bj = 0; bj < 2; ++bj) { bv[bj][0] = *(const f32x4*)(bmerge + c0 + bj * 128) * (-1.4426950408889634f); bv[bj][1] = *(const f32x4*)(bmerge + c0 + bj * 128 + 4) * (-1.4426950408889634f); }
#pragma unroll
            for (int ai = 0; ai < 2; ++ai)
#pragma unroll
                for (int m = 0; m < 4; ++m) { unsigned char* rp = (unsigned char*)GT + (size_t)(row0 + ai * 128 + m * 16) * 2048 + c0;
#pragma unroll
                    for (int bj = 0; bj < 2; ++bj) { const f32x4 v0 = sigmoid4_a32(acc[ai][bj][m][0], bv[bj][0]), v1 = sigmoid4_a32(acc[ai][bj][m][1], bv[bj][1]);
                        u32x2 w; w.x = cvt_pk4_fp8(v0[0], v0[1], v0[2], v0[3]); w.y = cvt_pk4_fp8(v1[0], v1[1], v1[2], v1[3]); *(u32x2*)(rp + bj * 128) = w; } }
        }
    }
};
struct EpiQ {
    static constexpr bool IDEM = true;
    bf16_t* Q; const float* rcos; const float* rsin; float sc;
    __device__ __forceinline__ void operator()(AccRef acc, const Unit& u, int wr, int wc, int fr, int fq) const {
        const int row0 = u.pm * 256 + wr * 64 + fr, cb = u.pn * 256 + wc * 32 + 8 * fq;
        const int bl = u.pm / 9; const bool lat = (u.pm - bl * 9) != 0;
        const int hc0 = cb % 192, hc1 = (cb + 128) % 192; const bool rot0 = lat && hc0 >= 128, rot1 = lat && hc1 >= 128;
        const int i00 = rot0 ? (hc0 - 128) >> 1 : 0, i01 = rot1 ? (hc1 - 128) >> 1 : 0;
#pragma unroll
        for (int ai = 0; ai < 2; ++ai) {
            f32x4 cs[4][2], sn[4][2];
#pragma unroll
            for (int m = 0; m < 4; ++m) { const int row = row0 + ai * 128 + m * 16; const int pos = row - bl * RPB - CTX;
                if (rot0) { cs[m][0] = *(const f32x4*)(rcos + pos * 32 + i00); sn[m][0] = *(const f32x4*)(rsin + pos * 32 + i00); }
                if (rot1) { cs[m][1] = *(const f32x4*)(rcos + pos * 32 + i01); sn[m][1] = *(const f32x4*)(rsin + pos * 32 + i01); } }
            asm volatile("" ::: "memory");
#pragma unroll
            for (int m = 0; m < 4; ++m) { const int row = row0 + ai * 128 + m * 16; unsigned char* rp = (unsigned char*)Q + (size_t)row * 1536 + cb;
#pragma unroll
                for (int bj = 0; bj < 2; ++bj) { f32x4 v0 = acc[ai][bj][m][0] * sc, v1 = acc[ai][bj][m][1] * sc;
                    if (bj == 0 ? rot0 : rot1) { const f32x4 o1 = v0 * cs[m][bj] - v1 * sn[m][bj], o2 = v0 * sn[m][bj] + v1 * cs[m][bj]; v0 = o1; v1 = o2; }
                    u32x2 w; w.x = cvt_pk4_fp8(v0[0], v0[1], v0[2], v0[3]); w.y = cvt_pk4_fp8(v1[0], v1[1], v1[2], v1[3]); *(u32x2*)(rp + bj * 128) = w; } }
            asm volatile("" ::: "memory");
        }
    }
};
struct EpiStore {
    static constexpr bool IDEM = true;
    unsigned char* VT; int ldc; float sc; unsigned char* KN;
    __device__ __forceinline__ void operator()(AccRef acc, const Unit& u, int wr, int wc, int fr, int fq) const {
        const int row0 = u.pm * 256 + wr * 64 + fr, cb = u.pn * 256 + wc * 32 + 8 * fq;
#pragma unroll
        for (int ai = 0; ai < 2; ++ai)
#pragma unroll
            for (int m = 0; m < 4; ++m) { const size_t row = (size_t)(row0 + ai * 128 + m * 16);
                { const f32x4 v0 = acc[ai][0][m][0] * sc, v1 = acc[ai][0][m][1] * sc; u32x2 w; w.x = cvt_pk4_fp8(v0[0], v0[1], v0[2], v0[3]); w.y = cvt_pk4_fp8(v1[0], v1[1], v1[2], v1[3]);
                  *(u32x2*)(KN + row * 1024 + u.pn * 128 + wc * 32 + 8 * fq) = w; }
                { const f32x4 v0 = acc[ai][1][m][0] * sc, v1 = acc[ai][1][m][1] * sc; const unsigned w0 = cvt_pk4_fp8(v0[0], v0[1], v0[2], v0[3]), w1 = cvt_pk4_fp8(v1[0], v1[1], v1[2], v1[3]);
                  const int key = (int)(row & 63), slot = ((key >> 2) & 1) * 32 + (key >> 5) * 16 + ((key >> 3) & 3) * 4 + (key & 3);
                  unsigned char* vp = VT + (((row >> 6) * 8 + u.pn) * 128 + wc * 32 + 8 * fq) * 64 + slot;
#pragma unroll
                  for (int j = 0; j < 4; ++j) { vp[j * 64] = (unsigned char)(w0 >> (8 * j)); vp[(j + 4) * 64] = (unsigned char)(w1 >> (8 * j)); } } }
    }
};
template <bool ADD> struct EpiProj {
    static constexpr bool IDEM = true;
    bf16_t* Y; const bf16_t* GT; int goff; unsigned char* Y8; float sc;
    __device__ __forceinline__ void operator()(AccRef acc, const Unit& u, int wr, int wc, int fr, int fq) const {
        const int row0 = u.pm * 256 + wr * 64 + fr, cb = u.pn * 256 + wc * 32 + 8 * fq;
#pragma unroll
        for (int ai = 0; ai < 2; ++ai) {
            u32x2 gw[4][2]; u32x4 yw[4][2];
#pragma unroll
            for (int m = 0; m < 4; ++m) { const size_t row = (size_t)(row0 + ai * 128 + m * 16);
#pragma unroll
                for (int bj = 0; bj < 2; ++bj) { const int c = cb + bj * 128;
                    gw[m][bj] = *(const u32x2*)((const unsigned char*)GT + row * 2048 + goff + c);
                    if (ADD) yw[m][bj] = *(const u32x4*)(Y + row * 1024 + c); } }
            asm volatile("" ::: "memory");
#pragma unroll
            for (int m = 0; m < 4; ++m) { const size_t row = (size_t)(row0 + ai * 128 + m * 16);
#pragma unroll
                for (int bj = 0; bj < 2; ++bj) { const int c = cb + bj * 128;
                    const f32x4 g0 = fp8x4_f32(gw[m][bj].x), g1 = fp8x4_f32(gw[m][bj].y);
                    f32x4 v0 = acc[ai][bj][m][0] * sc, v1 = acc[ai][bj][m][1] * sc;
                    if (ADD && DBG_NOATT) { v0 = v0 * 0.f; v1 = v1 * 0.f; }
                    if (!ADD && DBG_NOGMB) { v0 = v0 * 0.f; v1 = v1 * 0.f; }
                    if (ADD || !DBG_GA1) { v0 = v0 * g0; v1 = v1 * g1; }
                    if (ADD) { const u32x4 y4 = yw[m][bj];
                        v0[0] += bf_lo(y4.x); v0[1] += bf_hi(y4.x); v0[2] += bf_lo(y4.y); v0[3] += bf_hi(y4.y);
                        v1[0] += bf_lo(y4.z); v1[1] += bf_hi(y4.z); v1[2] += bf_lo(y4.w); v1[3] += bf_hi(y4.w);
                        u32x2 w; w.x = cvt_pk4_fp8(v0[0], v0[1], v0[2], v0[3]); w.y = cvt_pk4_fp8(v1[0], v1[1], v1[2], v1[3]); *(u32x2*)(Y8 + row * 1024 + c) = w; }
                    else st_bf16x8(Y + row * 1024 + c, v0, v1); } }
            asm volatile("" ::: "memory");
        }
    }
};
struct EpiOut {
    static constexpr bool IDEM = false;
    bf16_t* LAT; const float* x; const float* ctx; const float* mod; int g, first;
    __device__ __forceinline__ void operator()(AccRef acc, const Unit& u, int wr, int wc, int fr, int fq) const {
        const int row0 = u.pm * 256 + wr * 64 + fr, cb = u.pn * 256 + wc * 32 + 8 * fq;
        const int bl = u.pm / 9, isctx = (u.pm - bl * 9) == 0, gb = g * GB + bl;
        const float* g1 = mod + (size_t)(isctx ? 32 : gb) * 6144 + 2048 + cb;
        f32x4 gv[2][2];
#pragma unroll
        for (int bj = 0; bj < 2; ++bj) { gv[bj][0] = *(const f32x4*)(g1 + bj * 128) * (1.0f / WO_SCALE); gv[bj][1] = *(const f32x4*)(g1 + bj * 128 + 4) * (1.0f / WO_SCALE); }
        if (first) body<true>(acc, row0, cb, bl, isctx, gb, gv); else body<false>(acc, row0, cb, bl, isctx, gb, gv);
    }
    template <bool FIRST> __device__ __forceinline__ void body(AccRef acc, int row0, int cb, int bl, int isctx, int gb, const f32x4 (&gv)[2][2]) const {
#pragma unroll
        for (int ai = 0; ai < 2; ++ai)
#pragma unroll
            for (int mp = 0; mp < 2; ++mp) {
                f32x4 r0[2][2], r1[2][2];
#pragma unroll
                for (int mm = 0; mm < 2; ++mm) { const int row = row0 + ai * 128 + (mp * 2 + mm) * 16; const int rr = row - bl * RPB;
                    const float* res = isctx ? ctx + ((size_t)gb * CTX + rr) * 1024 : x + ((size_t)gb * SEQ + (rr - CTX)) * 1024;
                    const bf16_t* op = LAT + (size_t)row * 1024;
#pragma unroll
                    for (int bj = 0; bj < 2; ++bj) { const int c = cb + bj * 128;
                        if (FIRST) { r0[mm][bj] = *(const f32x4*)(res + c); r1[mm][bj] = *(const f32x4*)(res + c + 4); }
                        else { const u32x4 w = *(const u32x4*)(op + c); r0[mm][bj] = (f32x4){bf_lo(w.x), bf_hi(w.x), bf_lo(w.y), bf_hi(w.y)}; r1[mm][bj] = (f32x4){bf_lo(w.z), bf_hi(w.z), bf_lo(w.w), bf_hi(w.w)}; } } }
                asm volatile("" ::: "memory");
#pragma unroll
                for (int mm = 0; mm < 2; ++mm) { const int m = mp * 2 + mm; bf16_t* op = LAT + (size_t)(row0 + ai * 128 + m * 16) * 1024;
#pragma unroll
                    for (int bj = 0; bj < 2; ++bj) st_bf16x8(op + cb + bj * 128, ALPHA * r0[mm][bj] + gv[bj][0] * acc[ai][bj][m][0], ALPHA * r1[mm][bj] + gv[bj][1] * acc[ai][bj][m][1]); }
                asm volatile("" ::: "memory");
            }
    }
};
struct MoeOrder {
    static constexpr bool GATHER = false;
    const volatile LAS int* pre;
    int G, c;
    __device__ __forceinline__ bool next(int i, Unit& u) const {
        int tix, pn4;
        if ((G & 31) == 0) { const int x = c & 7, k = c >> 3; tix = i * (G >> 2) + x * (G >> 5) + (k >> 2); pn4 = k & 3; }
        else { const int L = i * G + c; tix = L >> 2; pn4 = L & 3; }
        int ln; asm volatile("v_mbcnt_lo_u32_b32 %0, -1, 0\n\tv_mbcnt_hi_u32_b32 %0, -1, %0" : "=v"(ln));
        const int pl = pre[ln < 17 ? ln : 16];
        const int ntile = __builtin_amdgcn_readlane(pl, 16); if (tix >= ntile) return false;
        const int e = __popcll(__ballot(ln >= 1 && ln < 16 && tix >= pl));
        u.pm = tix - __builtin_amdgcn_readlane(pl, e); u.pn = pn4; u.bt = e * 4 + u.pn; u.aux = e; return true;
    }
    __device__ __forceinline__ unsigned arow(const Unit& u, int r) const { return (unsigned)(__builtin_amdgcn_readfirstlane(pre[33 + u.aux]) + u.pm * 256 + r); }
};
struct EpiGU {
    static constexpr bool IDEM = true;
    bf16_t* ACT; const volatile LAS int* pre;
    __device__ __forceinline__ void operator()(AccRef acc, const Unit& u, int wr, int wc, int fr, int fq) const {
        const int n = pre[17 + u.aux], eb = pre[33 + u.aux]; const int cb = (u.pn * 256 + wc * 32 + 8 * fq) >> 1;
#pragma unroll
        for (int ai = 0; ai < 2; ++ai)
#pragma unroll
            for (int m = 0; m < 4; ++m) { const int idx = u.pm * 256 + ai * 128 + wr * 64 + m * 16 + fr;
                if (idx < n) { unsigned char* rp = (unsigned char*)ACT + (size_t)(eb + idx) * DE + cb;
#pragma unroll
                    for (int bj = 0; bj < 2; ++bj) { const f32x4 ag = acc[ai][bj][m][0], au = acc[ai][bj][m][1]; const f32x4 arg = ag * (-0.0450842200f); f32x4 r;
#pragma unroll
                        for (int j = 0; j < 4; ++j) r[j] = __builtin_amdgcn_rcpf(__builtin_amdgcn_exp2f(arg[j]) * 1024.0f + 1024.0f);
                        const f32x4 o = ag * au * r;
                        *(unsigned*)(rp + bj * 64) = cvt_pk4_fp8(o[0], o[1], o[2], o[3]); } } }
    }
};
struct EpiDown {
    static constexpr bool IDEM = true;
    bf16_t* OUT; const volatile LAS int* pre;
    __device__ __forceinline__ void operator()(AccRef acc, const Unit& u, int wr, int wc, int fr, int fq) const {
        const int n = pre[17 + u.aux], eb = pre[33 + u.aux]; const int cb = u.pn * 256 + wc * 32 + 8 * fq;
#pragma unroll
        for (int ai = 0; ai < 2; ++ai)
#pragma unroll
            for (int m = 0; m < 4; ++m) { const int idx = u.pm * 256 + ai * 128 + wr * 64 + m * 16 + fr;
                if (idx < n) { unsigned char* rp = (unsigned char*)OUT + (size_t)(eb + idx) * 1024 + cb;
#pragma unroll
                    for (int bj = 0; bj < 2; ++bj) { const f32x4 v0 = acc[ai][bj][m][0] * (OUT_SCALE / WIN_SCALE), v1 = acc[ai][bj][m][1] * (OUT_SCALE / WIN_SCALE);
                        u32x2 w; w.x = cvt_pk4_fp8(v0[0], v0[1], v0[2], v0[3]); w.y = cvt_pk4_fp8(v1[0], v1[1], v1[2], v1[3]); *(u32x2*)(rp + bj * 128) = w; } } }
    }
};

namespace att {
constexpr int KVBLK = 64;
constexpr int SHM_V = KVBLK * 128, SHM_K = KVBLK * 256;
constexpr int K_OFF = 0, V_OFF = 3 * SHM_K, WSC_OFF = V_OFF + 3 * SHM_V, SHM_ATTN = WSC_OFF + 8 * 64 * 4;
constexpr float SCALE = 0.07216878364870322f;
constexpr float THR = 5.f;
#define SBAR() __builtin_amdgcn_sched_barrier(0)
typedef int i32x8a __attribute__((ext_vector_type(8)));
__device__ __forceinline__ int crow(int r, int hi) { return (r & 3) + 8 * (r >> 2) + 4 * hi; }
__device__ __forceinline__ void partialSM(f32x16& p0, f32x16& p1, float& m_reg, float& mn, float& alpha) {
  constexpr float C = SCALE * 1.4426950408889634f;
  float pmax = p0[0];
#pragma unroll
  for (int r = 1; r < 16; ++r) pmax = fmaxf(pmax, p0[r]);
#pragma unroll
  for (int r = 0; r < 16; ++r) pmax = fmaxf(pmax, p1[r]);
  { auto rr = __builtin_amdgcn_permlane32_swap(__float_as_uint(pmax), __float_as_uint(pmax), false, false);
    pmax = fmaxf(__uint_as_float(rr[0]), __uint_as_float(rr[1])); }
  if (__builtin_expect(__all(pmax - m_reg <= THR / SCALE), 1)) { mn = m_reg; alpha = 1.f; }
  else { mn = fmaxf(m_reg, pmax); alpha = __builtin_amdgcn_exp2f((m_reg - mn) * C); m_reg = mn; }
  float mnC = -mn * C;
#pragma unroll
  for (int r = 0; r < 16; ++r) p0[r] = fmaf(p0[r], C, mnC);
#pragma unroll
  for (int r = 0; r < 16; ++r) p1[r] = fmaf(p1[r], C, mnC);
#pragma unroll
  for (int r = 0; r < 16; ++r) p0[r] = __builtin_amdgcn_exp2f(p0[r]);
}
__device__ __forceinline__ void finishSM(f32x16& p0, f32x16& p1, float alpha, float& l_reg, bf16x8& pa0, bf16x8& pa1, bf16x8& pa2, bf16x8& pa3) {
#pragma unroll
  for (int r = 0; r < 16; ++r) p1[r] = __builtin_amdgcn_exp2f(p1[r]);
  float ps = 0;
#pragma unroll
  for (int r = 0; r < 16; ++r) ps += p0[r];
#pragma unroll
  for (int r = 0; r < 16; ++r) ps += p1[r];
  { auto rr = __builtin_amdgcn_permlane32_swap(__float_as_uint(ps), __float_as_uint(ps), false, false);
    ps = __uint_as_float(rr[0]) + __uint_as_float(rr[1]); }
  l_reg = l_reg * alpha + ps;
#define PK4(P, BASE, OUT) do { unsigned a0 = cvt_pk_bf16(P[BASE + 0], P[BASE + 1]), a1 = cvt_pk_bf16(P[BASE + 2], P[BASE + 3]);   \
    unsigned b0 = cvt_pk_bf16(P[BASE + 4], P[BASE + 5]), b1 = cvt_pk_bf16(P[BASE + 6], P[BASE + 7]);                              \
    auto r0 = __builtin_amdgcn_permlane32_swap(a0, b0, false, false); auto r1 = __builtin_amdgcn_permlane32_swap(a1, b1, false, false); \
    u32x4 w = {r0[0], r1[0], r0[1], r1[1]}; OUT = *reinterpret_cast<bf16x8*>(&w); } while (0)
  PK4(p0, 0, pa0); PK4(p0, 8, pa1); PK4(p1, 0, pa2); PK4(p1, 8, pa3);
#undef PK4
}
__device__ __forceinline__ void qkt(f32x16& p0, f32x16& p1, const LAS char* Ks, const i32x8a* qf, int ka0, int ka1, int ka2) {
  p0 = f32x16{}; p1 = f32x16{};
#pragma unroll
  for (int s = 0; s < 3; ++s) { const int ka = s == 0 ? ka0 : s == 1 ? ka1 : ka2;
    const u32x4 l0 = *reinterpret_cast<const LAS u32x4*>(Ks + ka), h0 = *reinterpret_cast<const LAS u32x4*>(Ks + (ka ^ 16));
    const u32x4 l1 = *reinterpret_cast<const LAS u32x4*>(Ks + ka + 32 * 256), h1 = *reinterpret_cast<const LAS u32x4*>(Ks + (ka ^ 16) + 32 * 256);
    const i32x8a a0 = {(int)l0.x, (int)l0.y, (int)l0.z, (int)l0.w, (int)h0.x, (int)h0.y, (int)h0.z, (int)h0.w};
    const i32x8a a1 = {(int)l1.x, (int)l1.y, (int)l1.z, (int)l1.w, (int)h1.x, (int)h1.y, (int)h1.z, (int)h1.w};
    p0 = __builtin_amdgcn_mfma_scale_f32_32x32x64_f8f6f4(a0, qf[s], p0, 0, 0, 0, 0x7f7f7f7f, 0, 0x7f7f7f7f);
    p1 = __builtin_amdgcn_mfma_scale_f32_32x32x64_f8f6f4(a1, qf[s], p1, 0, 0, 0, 0x7f7f7f7f, 0, 0x7f7f7f7f); }
}
__device__ __forceinline__ void finishSM8(f32x16& p0, f32x16& p1, i32x8a& p8) {
#pragma unroll
  for (int r = 0; r < 16; ++r) p1[r] = __builtin_amdgcn_exp2f(p1[r]);
  p8 = (i32x8a){(int)cvt_pk4_fp8(p0[0], p0[1], p0[2], p0[3]), (int)cvt_pk4_fp8(p0[4], p0[5], p0[6], p0[7]), (int)cvt_pk4_fp8(p0[8], p0[9], p0[10], p0[11]), (int)cvt_pk4_fp8(p0[12], p0[13], p0[14], p0[15]),
                (int)cvt_pk4_fp8(p1[0], p1[1], p1[2], p1[3]), (int)cvt_pk4_fp8(p1[4], p1[5], p1[6], p1[7]), (int)cvt_pk4_fp8(p1[8], p1[9], p1[10], p1[11]), (int)cvt_pk4_fp8(p1[12], p1[13], p1[14], p1[15])};
}
#define LD8A(dst, base, off) do { const u32x4 l_ = *reinterpret_cast<const LAS u32x4*>((base) + (off)), h_ = *reinterpret_cast<const LAS u32x4*>((base) + ((off) ^ 16)); \
    dst = (i32x8a){(int)l_.x, (int)l_.y, (int)l_.z, (int)l_.w, (int)h_.x, (int)h_.y, (int)h_.z, (int)h_.w}; } while (0)
template <bool PV> __device__ __forceinline__ void mseg(f32x16& p0, f32x16& p1, const LAS char* Ks, const i32x8a* qf, int ka0, int ka1, int ka2, f32x16* o, const LAS char* Vs, int vx, i32x8a p8) {
  i32x8a k0[3], k1[3], vf[4];
  LD8A(k0[0], Ks, ka0); LD8A(k1[0], Ks + 32 * 256, ka0); LD8A(k0[1], Ks, ka1); LD8A(k1[1], Ks + 32 * 256, ka1); LD8A(k0[2], Ks, ka2); LD8A(k1[2], Ks + 32 * 256, ka2);
  SBAR();
  p0 = __builtin_amdgcn_mfma_scale_f32_32x32x64_f8f6f4(k0[0], qf[0], f32x16{}, 0, 0, 0, 0x7f7f7f7f, 0, 0x7f7f7f7f);
  p1 = __builtin_amdgcn_mfma_scale_f32_32x32x64_f8f6f4(k1[0], qf[0], f32x16{}, 0, 0, 0, 0x7f7f7f7f, 0, 0x7f7f7f7f);
  if (PV) { LD8A(vf[0], Vs, vx); LD8A(vf[1], Vs + 2048, vx); }
  SBAR();
  p0 = __builtin_amdgcn_mfma_scale_f32_32x32x64_f8f6f4(k0[1], qf[1], p0, 0, 0, 0, 0x7f7f7f7f, 0, 0x7f7f7f7f);
  p1 = __builtin_amdgcn_mfma_scale_f32_32x32x64_f8f6f4(k1[1], qf[1], p1, 0, 0, 0, 0x7f7f7f7f, 0, 0x7f7f7f7f);
  if (PV) { LD8A(vf[2], Vs + 4096, vx); LD8A(vf[3], Vs + 6144, vx); }
  SBAR();
  p0 = __builtin_amdgcn_mfma_scale_f32_32x32x64_f8f6f4(k0[2], qf[2], p0, 0, 0, 0, 0x7f7f7f7f, 0, 0x7f7f7f7f);
  p1 = __builtin_amdgcn_mfma_scale_f32_32x32x64_f8f6f4(k1[2], qf[2], p1, 0, 0, 0, 0x7f7f7f7f, 0, 0x7f7f7f7f);
  if (PV) {
    SBAR();
    { int one8 = 0x38383838; asm volatile("" : "+v"(one8)); const i32x8a ones = {one8, one8, one8, one8, one8, one8, one8, one8};
      o[4] = __builtin_amdgcn_mfma_scale_f32_32x32x64_f8f6f4(p8, ones, o[4], 0, 0, 0, 0x7f7f7f7f, 0, 0x7f7f7f7f); }
#pragma unroll
    for (int d0 = 0; d0 < 4; ++d0) o[d0] = __builtin_amdgcn_mfma_scale_f32_32x32x64_f8f6f4(p8, vf[d0], o[d0], 0, 0, 0, 0x7f7f7f7f, 0, 0x7f7f7f7f);
  }
}
__device__ __forceinline__ void pv8(f32x16* o, const LAS char* Vs, int vx, i32x8a p8) {
  { int one8 = 0x38383838; asm volatile("" : "+v"(one8)); const i32x8a ones = {one8, one8, one8, one8, one8, one8, one8, one8};
    o[4] = __builtin_amdgcn_mfma_scale_f32_32x32x64_f8f6f4(p8, ones, o[4], 0, 0, 0, 0x7f7f7f7f, 0, 0x7f7f7f7f); }
#pragma unroll
  for (int d0 = 0; d0 < 4; ++d0) {
    const u32x4 l = *reinterpret_cast<const LAS u32x4*>(Vs + d0 * 2048 + vx), h = *reinterpret_cast<const LAS u32x4*>(Vs + d0 * 2048 + (vx ^ 16));
    const i32x8a b = {(int)l.x, (int)l.y, (int)l.z, (int)l.w, (int)h.x, (int)h.y, (int)h.z, (int)h.w};
    o[d0] = __builtin_amdgcn_mfma_scale_f32_32x32x64_f8f6f4(p8, b, o[d0], 0, 0, 0, 0x7f7f7f7f, 0, 0x7f7f7f7f); }
}
__device__ __forceinline__ int v_st(int k, int c) { const int kk = (k & ~0xC) | ((k & 4) << 1) | ((k & 8) >> 1); return ((kk >> 3) * 4 + (c >> 5)) * 512 + ((kk & 7) * 32 + (c & 31)) * 2; }
__device__ __forceinline__ int v_rd_base(int lane) { return ((lane & 3) << 3) | (((lane >> 2) & 3) << 6) | (((lane >> 4) & 1) << 5) | (((lane >> 5) & 1) << 8); }
constexpr int v_rd_off(int d0, int ks, int half) { return d0 * 512 + ks * 4096 + half * 2048; }
template <int OFF> __device__ __forceinline__ s16x4 tr_read(int vb) {
  s16x4 r; asm volatile("ds_read_b64_tr_b16 %0, %1 offset:%2" : "=&v"(r) : "v"(vb), "i"(OFF) : "memory"); return r;
}
template <int D0> __device__ __forceinline__ void pv_one(f32x16& od, int vb, bf16x8 pa0, bf16x8 pa1, bf16x8 pa2, bf16x8 pa3) {
  const s16x4 l0 = tr_read<v_rd_off(D0, 0, 0)>(vb), h0 = tr_read<v_rd_off(D0, 0, 1)>(vb), l1 = tr_read<v_rd_off(D0, 1, 0)>(vb), h1 = tr_read<v_rd_off(D0, 1, 1)>(vb);
  const s16x4 l2 = tr_read<v_rd_off(D0, 2, 0)>(vb), h2 = tr_read<v_rd_off(D0, 2, 1)>(vb), l3 = tr_read<v_rd_off(D0, 3, 0)>(vb), h3 = tr_read<v_rd_off(D0, 3, 1)>(vb);
  asm volatile("s_waitcnt lgkmcnt(0)" ::: "memory"); SBAR();
#define PK(L, H) (bf16x8){L[0], L[1], L[2], L[3], H[0], H[1], H[2], H[3]}
  od = __builtin_amdgcn_mfma_f32_32x32x16_bf16(pa0, PK(l0, h0), od, 0, 0, 0);
  od = __builtin_amdgcn_mfma_f32_32x32x16_bf16(pa1, PK(l1, h1), od, 0, 0, 0);
  od = __builtin_amdgcn_mfma_f32_32x32x16_bf16(pa2, PK(l2, h2), od, 0, 0, 0);
  od = __builtin_amdgcn_mfma_f32_32x32x16_bf16(pa3, PK(l3, h3), od, 0, 0, 0);
#undef PK
}
template <int D0> __device__ __forceinline__ void pv_one_t(f32x16& od, int vb, bf16x8 pa0, bf16x8 pa1, bf16x8 pa2, bf16x8 pa3) {
  const s16x4 l0 = tr_read<v_rd_off(D0, 0, 0)>(vb), h0 = tr_read<v_rd_off(D0, 0, 1)>(vb), l1 = tr_read<v_rd_off(D0, 1, 0)>(vb), h1 = tr_read<v_rd_off(D0, 1, 1)>(vb);
  const s16x4 l2 = tr_read<v_rd_off(D0, 2, 0)>(vb), h2 = tr_read<v_rd_off(D0, 2, 1)>(vb), l3 = tr_read<v_rd_off(D0, 3, 0)>(vb), h3 = tr_read<v_rd_off(D0, 3, 1)>(vb);
  asm volatile("s_waitcnt lgkmcnt(0)" ::: "memory"); SBAR();
#define PK(L, H) (bf16x8){L[0], L[1], L[2], L[3], H[0], H[1], H[2], H[3]}
  od = __builtin_amdgcn_mfma_f32_32x32x16_bf16(PK(l0, h0), pa0, od, 0, 0, 0);
  od = __builtin_amdgcn_mfma_f32_32x32x16_bf16(PK(l1, h1), pa1, od, 0, 0, 0);
  od = __builtin_amdgcn_mfma_f32_32x32x16_bf16(PK(l2, h2), pa2, od, 0, 0, 0);
  od = __builtin_amdgcn_mfma_f32_32x32x16_bf16(PK(l3, h3), pa3, od, 0, 0, 0);
#undef PK
}
__device__ __forceinline__ void pv_d0(f32x16* o, int vb, bf16x8 pa0, bf16x8 pa1, bf16x8 pa2, bf16x8 pa3) {
  pv_one<0>(o[0], vb, pa0, pa1, pa2, pa3); pv_one<1>(o[1], vb, pa0, pa1, pa2, pa3); pv_one<2>(o[2], vb, pa0, pa1, pa2, pa3); pv_one<3>(o[3], vb, pa0, pa1, pa2, pa3);
}
__device__ __forceinline__ void attn_body(const unsigned char* __restrict__ Qb, const unsigned char* __restrict__ wsb, unsigned vto, unsigned kno, unsigned kro, bf16_t* __restrict__ Ob, int ntile, LAS char* lds, int tid) {
  const int wid = __builtin_amdgcn_readfirstlane(tid >> 6), lane = tid & 63, r32 = lane & 31, hi = lane >> 5;
  LAS float* wsp = (LAS float*)(lds + WSC_OFF) + wid * 64; LAS float* li_l = wsp; LAS float* al_l = wsp + 32;
  float m_reg = -1e30f; f32x16 o[5] = {}; i32x8a qr[3];
  const unsigned char* Qw = Qb + (size_t)(wid * 32 + r32) * 1536 + hi * 32;
#pragma unroll
  for (int s3 = 0; s3 < 3; ++s3) { const u32x4 ql = *reinterpret_cast<const u32x4*>(Qw + s3 * 64), qh = *reinterpret_cast<const u32x4*>(Qw + s3 * 64 + 16);
    qr[s3] = (i32x8a){(int)ql.x, (int)ql.y, (int)ql.z, (int)ql.w, (int)qh.x, (int)qh.y, (int)qh.z, (int)qh.w}; }
  unsigned ko0, ko1, ki0, ki1, vo0;
#define KSRC(i, KO, KI) do { const int p = (wid * 2 + (i)) * 64 + lane, row = p >> 4, c = (p & 15) ^ (row & 15); \
    if (c >= 8 && c < 12) { KO = kro + (unsigned)(row * 64 + (c - 8) * 16); KI = KVBLK * 64; } else { KO = kno + (unsigned)(row * 1024 + (c < 8 ? c : 0) * 16); KI = KVBLK * 1024; } } while (0)
  KSRC(0, ko0, ki0); KSRC(1, ko1, ki1);
#undef KSRC
  { const int p = wid * 64 + lane, d = p >> 2, c = (p & 3) ^ ((d >> 2) & 3); vo0 = vto + (unsigned)(d * 64 + c * 16); }
  const int kxb = r32 * 256, sw = r32 & 15;
  const int kx0 = kxb + 16 * ((0 + 2 * hi) ^ sw), kx1 = kxb + 16 * ((4 + 2 * hi) ^ sw), kx2 = kxb + 16 * ((8 + 2 * hi) ^ sw);
  const int vx = r32 * 64 + 16 * ((2 * hi) ^ ((r32 >> 2) & 3));
#define GLDS(src, dst) __builtin_amdgcn_global_load_lds((const unsigned*)(src), (LAS unsigned*)(dst), 16, 0, 0)
#define ISSUE_K(t, slot) do { const unsigned _t = (unsigned)(t); LAS char* _d = lds + K_OFF + (slot) * SHM_K + wid * 2048; \
    GLDS(wsb + (ko0 + _t * ki0), _d); GLDS(wsb + (ko1 + _t * ki1), _d + 1024); } while (0)
#define ISSUE_V(t, slot) do { const unsigned _t = (unsigned)(t) * 65536u; LAS char* _d = lds + V_OFF + (slot) * SHM_V + wid * 1024; GLDS(wsb + (vo0 + _t), _d); } while (0)
#define RESC(a) do { if (__any((a) < 1.f)) { if (hi == 0) al_l[r32] = (a); asm volatile("s_waitcnt lgkmcnt(0)" ::: "memory"); \
    _Pragma("unroll") for (int d = 0; d < 5; ++d) _Pragma("unroll") for (int r = 0; r < 16; ++r) o[d][r] *= al_l[crow(r, hi)]; } } while (0)
  f32x16 pS0, pS1; float mnS, alS; i32x8a p8 = {};
  const int tl = ntile - 1; const bool lagh = wid >= 4;
#define BARX() do { SBAR(); __builtin_amdgcn_s_barrier(); SBAR(); } while (0)
  ISSUE_K(0, 0); ISSUE_V(0, 0); ISSUE_K(1, 1);
  asm volatile("s_waitcnt vmcnt(0)" ::: "memory"); __builtin_amdgcn_s_barrier();
  if (lagh) BARX();
  { const int tk = 2 < tl ? 2 : tl, tv = 1 < tl ? 1 : tl; ISSUE_K(tk, 2); ISSUE_V(tv, 1); }
  mseg<false>(pS0, pS1, lds + K_OFF, qr, kx0, kx1, kx2, o, lds + V_OFF, vx, p8);
  asm volatile("s_waitcnt vmcnt(3)" ::: "memory"); BARX();
  partialSM(pS0, pS1, m_reg, mnS, alS); RESC(alS); finishSM8(pS0, pS1, p8);
  BARX();
  int sj = 1;
  for (int j = 1; j <= tl; ++j) {
    const int s1 = sj == 2 ? 0 : sj + 1, s2 = s1 == 2 ? 0 : s1 + 1;
    { const int tk = j + 2 < tl ? j + 2 : tl, tv = j + 1 < tl ? j + 1 : tl; ISSUE_K(tk, s2); ISSUE_V(tv, s1); }
    SBAR(); mseg<true>(pS0, pS1, lds + K_OFF + sj * SHM_K, qr, kx0, kx1, kx2, o, lds + V_OFF + s2 * SHM_V, vx, p8);
    asm volatile("s_waitcnt vmcnt(3)" ::: "memory"); BARX();
    partialSM(pS0, pS1, m_reg, mnS, alS); RESC(alS); finishSM8(pS0, pS1, p8);
    BARX();
    sj = s1;
  }
  { const int sl = sj == 0 ? 2 : sj - 1; pv8(o, lds + V_OFF + sl * SHM_V, vx, p8); }
  if (!lagh) BARX();
#undef BARX
  asm volatile("s_waitcnt vmcnt(0) lgkmcnt(0)" ::: "memory"); __builtin_amdgcn_s_barrier();
  float rli[16];
#pragma unroll
  for (int r = 0; r < 16; ++r) rli[r] = ATT_SCALE * __builtin_amdgcn_rcpf(o[4][r]);
  unsigned char* Ow = (unsigned char*)Ob + (size_t)(wid * 32) * 1024;
  const unsigned sel1 = (lane & 1) ? 0x03070105u : 0x06020400u, sel2 = (lane & 2) ? 0x03020706u : 0x05040100u;
  unsigned char* Oq = Ow + (size_t)(4 * hi + (lane & 3)) * 1024 + 4 * (r32 >> 2);
#pragma unroll
  for (int d0 = 0; d0 < 4; ++d0)
#pragma unroll
    for (int k = 0; k < 4; ++k) {
      unsigned x = cvt_pk4_fp8(o[d0][4 * k] * rli[4 * k], o[d0][4 * k + 1] * rli[4 * k + 1], o[d0][4 * k + 2] * rli[4 * k + 2], o[d0][4 * k + 3] * rli[4 * k + 3]);
      const unsigned t1 = (unsigned)__builtin_amdgcn_update_dpp(0, (int)x, 0xB1, 0xf, 0xf, false);
      x = __builtin_amdgcn_perm(t1, x, sel1);
      const unsigned t2 = (unsigned)__builtin_amdgcn_update_dpp(0, (int)x, 0x4E, 0xf, 0xf, false);
      x = __builtin_amdgcn_perm(t2, x, sel2);
      *(unsigned*)(Oq + (size_t)(8 * k) * 1024 + d0 * 32) = x; }
#undef GLDS
#undef ISSUE_K
#undef ISSUE_V
#undef RESC
#undef STEP
}
}

__global__ void __launch_bounds__(NT, 2) mk_fwd(Params P) {
    extern __shared__ __attribute__((aligned(16))) unsigned char lds_raw[];
    LAS unsigned char* lds = (LAS unsigned char*)lds_raw;
    constexpr int MISC_OFF = 131072;
    volatile LAS unsigned* MISC = (volatile LAS unsigned*)(lds + MISC_OFF);
    volatile LAS int* PRE = (volatile LAS int*)(MISC + 16);
    const int G = gridDim.x, bid = blockIdx.x;
    const int wid0 = __builtin_amdgcn_readfirstlane(threadIdx.x >> 6);
    if (threadIdx.x < 64) MISC[threadIdx.x] = 0u;
    __syncthreads();
    XcdBarrier bar = xcd_barrier_post((unsigned*)(P.ws + WS_CTL) + CW_BAR, MISC);
#define PHASE_IDS() int wid = wid0; asm volatile("" : "+s"(wid)); int tid; asm volatile("v_mbcnt_lo_u32_b32 %0, -1, 0\n\tv_mbcnt_hi_u32_b32 %0, -1, %0" : "=v"(tid)); tid += wid * 64; const int lane = tid & 63; (void)lane; (void)wid; \
    GAS unsigned char* wsg_ = (GAS unsigned char*)P.ws; asm volatile("" : "+s"(wsg_)); unsigned char* ws = (unsigned char*)wsg_
#define WSP(T, off) ((T*)(ws + (off)))

    if (PH(0)) {
        PHASE_IDS();
        float* MOD = WSP(float, WS_MOD);
        REPS(0) {
        LAS float* red = (LAS float*)lds;
        for (int u = bid; u < 2 * 96; u += G) {
            const int l = u / 96, c0 = (u % 96) * 64;
            const float* W = P.in[I_WADA] + (size_t)l * 1024 * 6144 + c0 + lane;
            LAS float* tab = red + wid * 33 * 64;
            float acc[33];
#pragma unroll
            for (int r = 0; r < 33; ++r) acc[r] = 0.f;
            for (int p = 0; p < 2; ++p) { const int kb = wid * 128 + p * 64;
#pragma unroll
                for (int r = 0; r < 33; ++r) { const float cv = (r < 32) ? P.in[I_C][r * 1024 + kb + lane] : P.in[I_CCTX][kb + lane]; tab[r * 64 + lane] = cv / (1.0f + __expf(-cv)); }
                asm volatile("s_waitcnt lgkmcnt(0)" ::: "memory");
                float wv[2][16];
#pragma unroll
                for (int kk = 0; kk < 16; ++kk) wv[0][kk] = W[(size_t)(kb + kk) * 6144];
#pragma unroll
                for (int bt = 0; bt < 4; ++bt) {
                    if (bt < 3) {
#pragma unroll
                        for (int kk = 0; kk < 16; ++kk) wv[(bt + 1) & 1][kk] = W[(size_t)(kb + (bt + 1) * 16 + kk) * 6144]; }
#pragma unroll
                    for (int kq = 0; kq < 4; ++kq) {
                        const float w0 = wv[bt & 1][4 * kq], w1 = wv[bt & 1][4 * kq + 1], w2 = wv[bt & 1][4 * kq + 2], w3 = wv[bt & 1][4 * kq + 3];
#pragma unroll
                        for (int r0 = 0; r0 < 33; r0 += 11) { f32x4 t4[11];
#pragma unroll
                            for (int rr = 0; rr < 11; ++rr) t4[rr] = *(const LAS f32x4*)(tab + (r0 + rr) * 64 + bt * 16 + kq * 4);
#pragma unroll
                            for (int rr = 0; rr < 11; ++rr) acc[r0 + rr] = fmaf(t4[rr][3], w3, fmaf(t4[rr][2], w2, fmaf(t4[rr][1], w1, fmaf(t4[rr][0], w0, acc[r0 + rr])))); }
                        asm volatile("" ::: "memory"); } }
                asm volatile("s_waitcnt lgkmcnt(0)" ::: "memory"); }
            __syncthreads();
#pragma unroll
            for (int r = 0; r < 33; ++r) red[(wid * 33 + r) * 64 + lane] = acc[r];
            __syncthreads();
            for (int o = tid; o < 33 * 64; o += NT) { const int r = o >> 6, cl = o & 63; float sm = 0.f;
#pragma unroll
                for (int w = 0; w < 8; ++w) sm += red[(w * 33 + r) * 64 + cl];
                MOD[((size_t)l * 33 + r) * 6144 + c0 + cl] = sm + P.in[I_BADA][l * 6144 + c0 + cl]; }
            __syncthreads();
        }
        { float* RCOS = WSP(float, WS_ROPE); float* RSIN = RCOS + 2048 * 32;
          for (int i = bid * NT + tid; i < 2048 * 32; i += G * NT) { const int pos = i >> 5, f = i & 31; const int rw = pos >> 6, cl = pos & 63;
            const float inv = powf(10000.0f, -(float)(f & 15) / 16.0f); const float ang = (float)(f < 16 ? rw : cl) * inv;
            RCOS[i] = cosf(ang); RSIN[i] = sinf(ang); } }
        LAS float* tile = (LAS float*)lds;
#define XP_LOAD(t_, V) do { const int n0_ = ((t_) / ntk) * 64, k0_ = ((t_) % ntk) * 128; const int nl = tid & 63, kl = tid >> 6; const float* cp = colptr(n0_ + nl); \
        _Pragma("unroll") for (int kk = 0; kk < 16; ++kk) V[kk] = (cp && k0_ + kl + 8 * kk < kmax) ? cp[(size_t)(k0_ + kl + 8 * kk) * ld] : 0.f; } while (0)
#define XP_BAR() do { asm volatile("s_waitcnt lgkmcnt(0)" ::: "memory"); __builtin_amdgcn_s_barrier(); } while (0)
        auto xpose = [&](bf16_t* dst, int N, int K, int ld, auto colptr, int rot) {
            const int ntk = K / 128, ntot = (N / 64) * ntk, kmax = K;
            float v[16], vn[16]; int t = (bid + rot) % G;
            if (t < ntot) XP_LOAD(t, v);
            for (; t < ntot; t += G) {
                const int n0 = (t / ntk) * 64, k0 = (t % ntk) * 128;
                { const int tn = t + G < ntot ? t + G : t; XP_LOAD(tn, vn); }
                { const int nl = tid & 63, kl = tid >> 6;
#pragma unroll
                  for (int kk = 0; kk < 16; ++kk) tile[(kl + 8 * kk) * 65 + nl] = v[kk]; }
                XP_BAR();
                { const int n = tid & 63, k16 = (tid >> 6) * 16; u32x4 w0, w1;
                  w0.x = cvt_pk_bf16(tile[(k16 + 0) * 65 + n], tile[(k16 + 1) * 65 + n]); w0.y = cvt_pk_bf16(tile[(k16 + 2) * 65 + n], tile[(k16 + 3) * 65 + n]);
                  w0.z = cvt_pk_bf16(tile[(k16 + 4) * 65 + n], tile[(k16 + 5) * 65 + n]); w0.w = cvt_pk_bf16(tile[(k16 + 6) * 65 + n], tile[(k16 + 7) * 65 + n]);
                  w1.x = cvt_pk_bf16(tile[(k16 + 8) * 65 + n], tile[(k16 + 9) * 65 + n]); w1.y = cvt_pk_bf16(tile[(k16 + 10) * 65 + n], tile[(k16 + 11) * 65 + n]);
                  w1.z = cvt_pk_bf16(tile[(k16 + 12) * 65 + n], tile[(k16 + 13) * 65 + n]); w1.w = cvt_pk_bf16(tile[(k16 + 14) * 65 + n], tile[(k16 + 15) * 65 + n]);
                  u32x4* dp = (u32x4*)(dst + (size_t)(n0 + n) * K + k0 + k16); dp[0] = w0; dp[1] = w1; }
                XP_BAR();
#pragma unroll
                for (int kk = 0; kk < 16; ++kk) v[kk] = vn[kk];
            }
        };
        auto xpose8 = [&](unsigned char* dst, int N, int K, int ld, auto colptr, float scale, int kmax) {
            const int ntk = K / 128, ntot = (N / 64) * ntk;
            float v[16], vn[16], vm[16]; int t = bid;
            if (t < ntot) { XP_LOAD(t, v); const int t1 = t + G < ntot ? t + G : t; XP_LOAD(t1, vn); }
            for (; t < ntot; t += G) {
                const int n0 = (t / ntk) * 64, k0 = (t % ntk) * 128;
                { const int tn = t + 2 * G < ntot ? t + 2 * G : t; XP_LOAD(tn, vm); }
                { const int nl = tid & 63, kl = tid >> 6;
#pragma unroll
                  for (int kk = 0; kk < 16; ++kk) tile[(kl + 8 * kk) * 65 + nl] = v[kk] * scale; }
                XP_BAR();
                { const int n = tid & 63, k16 = (tid >> 6) * 16; u32x4 w;
                  w.x = cvt_pk4_fp8(tile[(k16 + 0) * 65 + n], tile[(k16 + 1) * 65 + n], tile[(k16 + 2) * 65 + n], tile[(k16 + 3) * 65 + n]);
                  w.y = cvt_pk4_fp8(tile[(k16 + 4) * 65 + n], tile[(k16 + 5) * 65 + n], tile[(k16 + 6) * 65 + n], tile[(k16 + 7) * 65 + n]);
                  w.z = cvt_pk4_fp8(tile[(k16 + 8) * 65 + n], tile[(k16 + 9) * 65 + n], tile[(k16 + 10) * 65 + n], tile[(k16 + 11) * 65 + n]);
                  w.w = cvt_pk4_fp8(tile[(k16 + 12) * 65 + n], tile[(k16 + 13) * 65 + n], tile[(k16 + 14) * 65 + n], tile[(k16 + 15) * 65 + n]);
                  *(u32x4*)(dst + (size_t)(n0 + n) * K + k0 + k16) = w; }
                XP_BAR();
#pragma unroll
                for (int kk = 0; kk < 16; ++kk) { v[kk] = vn[kk]; vn[kk] = vm[kk]; }
            }
        };
        { const float* src = P.in[I_WIN];
          xpose8(WSP(unsigned char, WS_WIN), 2 * NIN, 1024, IN_COLS, [=](int n) -> const float* { const int l = n / NIN, q = n - l * NIN; int col;
              if (q < 2048) col = q; else if (q < 2304) col = OFF_KV + (q - 2048); else if (q < 2368) col = OFF_KR + rope_orig(q - 2304);
              else if (q < 2752) col = OFF_Q + (q - 2368); else if (q < 2816) return (const float*)nullptr; else col = OFF_G + (q - 2816);
              return src + (size_t)l * 1024 * IN_COLS + col; }, WIN_SCALE, 1024); }
        { const float* src = P.in[I_WUQ];
          xpose8(WSP(unsigned char, WS_WUQ), 2 * 1536, 512, 1536, [=](int n) -> const float* { const int l = n / 1536, q = n - l * 1536; const int hd = q / 192, hc = q - hd * 192;
              const int col = hd * 192 + (hc < 128 ? hc : 128 + rope_orig(hc - 128)); return src + (size_t)l * 384 * 1536 + col; }, WU_SCALE, 384); }
        { const float* src = P.in[I_WUKV];
          xpose8(WSP(unsigned char, WS_WUKV), 2 * 2048, 256, 2048, [=](int n) -> const float* { const int l = n / 2048, q = n - l * 2048; return src + (size_t)l * 256 * 2048 + q; }, WU_SCALE, 256); }
        { const float* src = P.in[I_WPA];
          xpose8(WSP(unsigned char, WS_WPA), 2 * 1024, 1024, 1024, [=](int n) -> const float* { const int l = n >> 10, q = n & 1023; return src + (size_t)l * 1024 * 1024 + q; }, WIN_SCALE, 1024); }
        { const float* src = P.in[I_WPB];
          xpose8(WSP(unsigned char, WS_WPB), 2 * 1024, 1024, 1024, [=](int n) -> const float* { const int l = n >> 10, q = n & 1023; return src + (size_t)l * 1024 * 1024 + q; }, WIN_SCALE, 1024); }
        { const float* src = P.in[I_WOUT];
          xpose8(WSP(unsigned char, WS_WO), 2 * 1024, 1024, 1024, [=](int n) -> const float* { const int l = n >> 10, q = n & 1023; return src + (size_t)l * 1024 * 1024 + q; }, WO_SCALE, 1024); }
        { const float* sg = P.in[I_WEG]; const float* su = P.in[I_WEU];
          xpose8(WSP(unsigned char, WS_WGU), 32 * 1024, 1024, DE, [=](int n) -> const float* { const int le = n >> 10, q = n & 1023; const int ch = 4 * (q >> 3) + (q & 3);
              return ((q & 4) ? su : sg) + (size_t)le * 1024 * DE + ch; }, WIN_SCALE, 1024); }
        { const float* src = P.in[I_WED];
          xpose8(WSP(unsigned char, WS_WD), 32 * 1024, DE, 1024, [=](int n) -> const float* { const int le = n >> 10, q = n & 1023; return src + (size_t)le * DE * 1024 + q; }, WIN_SCALE, DE); }
        { bf16_t* WSB = WSP(bf16_t, WS_WS); for (int i = bid * NT + tid; i < 2 * 8 * 128 * 128; i += G * NT) WSB[i] = f2bf(P.in[I_GMWS][i]); }
        if (DBG_REP == 0) __syncthreads(); }
    }
    { PHASE_IDS(); (void)ws; xcd_barrier(bar, tid); }

#define DBG_DUMP(k, offA, offB) do { if (DBG_STOP == (k) && g == 0 && l == 0) { PHASE_IDS(); const bf16_t* A_ = WSP(const bf16_t, offA); const bf16_t* B_ = WSP(const bf16_t, offB); \
        const size_t nA_ = (size_t)TG * 1024, nO_ = (size_t)NB * SEQ * DM; \
        for (size_t i = (size_t)bid * NT + tid; i < nO_; i += (size_t)G * NT) P.out[i] = i < nA_ ? __uint_as_float((unsigned)A_[i] << 16) : __uint_as_float((unsigned)B_[i - nA_] << 16); \
        return; } } while (0)
    for (int g = 0; g < NG; ++g) {
        if (PH(1)) {
            PHASE_IDS();
            const float* MOD = WSP(const float, WS_MOD); bf16_t* H = WSP(bf16_t, WS_H);
            LAS u32x4* ML = (LAS u32x4*)lds;
            for (int o = tid; o < 17 * 256; o += NT) { const int mr = o >> 8, ci = o & 255; const float* mp = MOD + (size_t)(mr == 16 ? 32 : g * GB + mr) * 6144 + ci * 4;
                const f32x4 sh = *(const f32x4*)mp, sc = *(const f32x4*)(mp + 1024); u32x4 w;
                w.x = cvt_pk_bf16(sh[0], sh[1]); w.y = cvt_pk_bf16(sh[2], sh[3]); w.z = cvt_pk_bf16(1.0f + sc[0], 1.0f + sc[1]); w.w = cvt_pk_bf16(1.0f + sc[2], 1.0f + sc[3]); ML[o] = w; }
            __syncthreads();
            REPS(1)
            for (int r0 = bid * 8 + wid; r0 < TG; r0 += 4 * G * 8) {
                f32x4 xv[4][4];
#pragma unroll
                for (int k = 0; k < 4; ++k) { const int rq = r0 + k * G * 8; const int r = rq < TG ? rq : r0;
                    const int bl = r / RPB, rr = r - bl * RPB, gb = g * GB + bl;
                    const float* src = rr < CTX ? P.in[I_CTX] + ((size_t)gb * CTX + rr) * 1024 : P.in[I_X] + ((size_t)gb * SEQ + (rr - CTX)) * 1024;
#pragma unroll
                    for (int i = 0; i < 4; ++i) xv[k][i] = *(const f32x4*)(src + i * 256 + lane * 4); }
#pragma unroll
                for (int k = 0; k < 4; ++k) { const int r = r0 + k * G * 8;
                    if (r < TG) { const int bl = r / RPB, rr = r - bl * RPB; const int mo = (rr < CTX ? 16 : bl) * 256 + lane;
#pragma unroll
                        for (int i = 0; i < 4; ++i) { const int c = i * 256 + lane * 4; const u32x4 m = ML[mo + i * 64];
                            const f32x4 sh = {bf_lo(m.x), bf_hi(m.x), bf_lo(m.y), bf_hi(m.y)}, sc1 = {bf_lo(m.z), bf_hi(m.z), bf_lo(m.w), bf_hi(m.w)};
                            const f32x4 h = xv[k][i] * sc1 + sh; *(unsigned*)((unsigned char*)H + (size_t)r * 1024 + c) = cvt_pk4_fp8(h[0], h[1], h[2], h[3]); } }
                }
            }
            __syncthreads();
        }
        if ((DBG_STOP == 21 || DBG_STOP == 24) && g == 0) { PHASE_IDS(); unsigned* zz = WSP(unsigned, WS_Z); for (size_t i = (size_t)bid * NT + tid; i < (size_t)TG * 2048 * 2 * 2 / 4; i += (size_t)G * NT) zz[i] = 0x7fc07fc0u; }
        { PHASE_IDS(); (void)ws; xcd_barrier(bar, tid); }

        for (int l = 0; l < DEPTH; ++l) {
            const int last = (l == DEPTH - 1) ? 1 : 0;
            if (PH(2)) {
                PHASE_IDS();
                if (bid == 0 && tid < 16) __hip_atomic_store(WSP(unsigned, WS_CTL) + CW_CNT + tid, 0u, __ATOMIC_RELAXED, __HIP_MEMORY_SCOPE_AGENT);
                if ((DBG_STOP == 13 || DBG_STOP == 23 || DBG_STOP == 24) && bid == 0 && tid == 0) __hip_atomic_store(WSP(unsigned, WS_CTL) + CW_CNT + 33, 0xffffffffu, __ATOMIC_RELAXED, __HIP_MEMORY_SCOPE_AGENT);
                Gemm gm{ws + WS_H, WSP(const bf16_t, WS_WIN) + (size_t)l * NIN * 512, 512}; DenseOrder S;   S.init(last ? GB * 8 : NPAN, NIN / 256, G, bid, last, last ? 2 : 0, 8);
                EpiIn E{WSP(bf16_t, WS_Z), WSP(float, WS_MID), WSP(bf16_t, WS_GT), P.in[I_BMERGE] + l * 2048};
                pg8::gemm_phase<EpiIn, DenseOrder, true>(lds, gm, S, E, tid);
            }
            { PHASE_IDS(); (void)ws; xcd_barrier(bar, tid); }
            DBG_DUMP(2, WS_Z, WS_GT);
            if (DBG_STOP == 24 && g == 0 && l == 0) {
                { PHASE_IDS(); const unsigned* gw = WSP(const unsigned, WS_GT); unsigned cnt = 0, fb = 0xffffffffu;
                  for (size_t i = (size_t)bid * NT + tid; i < (size_t)NB * SEQ * DM; i += (size_t)G * NT) P.out[i] = 0.f;
                  for (size_t i = (size_t)bid * NT + tid; i < (size_t)TG * 1024; i += (size_t)G * NT) if (gw[i] != 0x7fc07fc0u) { ++cnt; fb = fb < (unsigned)i ? fb : (unsigned)i; }
                  if (cnt) atomicAdd(WSP(unsigned, WS_CTL) + CW_CNT + 32, cnt); atomicMin(WSP(unsigned, WS_CTL) + CW_CNT + 33, fb); }
                { PHASE_IDS(); (void)ws; xcd_barrier(bar, tid); }
                { PHASE_IDS(); if (bid == 0 && tid == 0) { const unsigned cnt = __hip_atomic_load(WSP(unsigned, WS_CTL) + CW_CNT + 32, __ATOMIC_RELAXED, __HIP_MEMORY_SCOPE_AGENT), fb = __hip_atomic_load(WSP(unsigned, WS_CTL) + CW_CNT + 33, __ATOMIC_RELAXED, __HIP_MEMORY_SCOPE_AGENT);
                      P.out[0] = DBG_SEL == 0 ? 10.f * (float)cnt : DBG_SEL == 1 ? 100.f * (float)(fb >> 10) : 100.f * (float)(fb & 1023); } }
                return; }
            if (DBG_STOP == 23 && g == 0 && l == 0) {
                { PHASE_IDS(); const bf16_t* Gp = WSP(const bf16_t, WS_GT); unsigned nn = 0, mx = 0, fb = 0xffffffffu;
                  for (size_t i = (size_t)bid * NT + tid; i < (size_t)NB * SEQ * DM; i += (size_t)G * NT) P.out[i] = 0.f;
                  for (size_t i = (size_t)bid * NT + tid; i < (size_t)TG * 2048; i += (size_t)G * NT) { const float v = __uint_as_float((unsigned)Gp[i] << 16);
                      if (v != v) ++nn; else { const unsigned b = __float_as_uint(fabsf(v)); mx = mx > b ? mx : b; }
                      if (!(fabsf(v) <= 2.f)) fb = fb < (unsigned)i ? fb : (unsigned)i; }
                  if (nn) atomicAdd(WSP(unsigned, WS_CTL) + CW_CNT + 32, nn); atomicMax(WSP(unsigned, WS_CTL) + CW_CNT + 34, mx); atomicMin(WSP(unsigned, WS_CTL) + CW_CNT + 33, fb); }
                { PHASE_IDS(); (void)ws; xcd_barrier(bar, tid); }
                { PHASE_IDS(); if (bid == 0 && tid == 0) { const unsigned nn = __hip_atomic_load(WSP(unsigned, WS_CTL) + CW_CNT + 32, __ATOMIC_RELAXED, __HIP_MEMORY_SCOPE_AGENT), mx = __hip_atomic_load(WSP(unsigned, WS_CTL) + CW_CNT + 34, __ATOMIC_RELAXED, __HIP_MEMORY_SCOPE_AGENT), fb = __hip_atomic_load(WSP(unsigned, WS_CTL) + CW_CNT + 33, __ATOMIC_RELAXED, __HIP_MEMORY_SCOPE_AGENT);
                      P.out[0] = DBG_SEL == 0 ? (nn ? 1e7f + (float)nn : 10.f * __uint_as_float(mx)) : DBG_SEL == 1 ? 100.f * (float)(fb >> 11) : 100.f * (float)(fb & 2047); } }
                return; }
            if (DBG_STOP == 22 && g == 0 && l == 0) {
                { PHASE_IDS(); const bf16_t* Zp = WSP(const bf16_t, DBG_SEL >= 2 ? WS_GT : WS_Z); unsigned* flagsR = WSP(unsigned, WS_KV); unsigned* flagsC = flagsR + TG;
                  for (size_t i = (size_t)bid * NT + tid; i < (size_t)TG + 2048; i += (size_t)G * NT) flagsR[i] = 0u;
                  for (size_t i = (size_t)bid * NT + tid; i < (size_t)NB * SEQ * DM; i += (size_t)G * NT) P.out[i] = 0.f; }
                { PHASE_IDS(); (void)ws; xcd_barrier(bar, tid); }
                { PHASE_IDS(); const bf16_t* Zp = WSP(const bf16_t, DBG_SEL >= 2 ? WS_GT : WS_Z); unsigned* flagsR = WSP(unsigned, WS_KV); unsigned* flagsC = flagsR + TG;
                  for (size_t i = (size_t)bid * NT + tid; i < (size_t)TG * 2048; i += (size_t)G * NT) { const float v = __uint_as_float((unsigned)Zp[i] << 16);
                      if (!(fabsf(v) <= (DBG_SEL >= 2 ? 2.f : 50.f))) { atomicOr(flagsR + (i >> 11), 1u); atomicOr(flagsC + (i & 2047), 1u); } } }
                { PHASE_IDS(); (void)ws; xcd_barrier(bar, tid); }
                { PHASE_IDS(); const unsigned* flagsR = WSP(const unsigned, WS_KV); const unsigned* flagsC = flagsR + TG; unsigned nr = 0, nc = 0;
                  for (size_t i = (size_t)bid * NT + tid; i < (size_t)TG; i += (size_t)G * NT) nr += __hip_atomic_load(flagsR + i, __ATOMIC_RELAXED, __HIP_MEMORY_SCOPE_AGENT);
                  for (size_t i = (size_t)bid * NT + tid; i < 2048; i += (size_t)G * NT) nc += __hip_atomic_load(flagsC + i, __ATOMIC_RELAXED, __HIP_MEMORY_SCOPE_AGENT);
                  if (nr) atomicAdd(WSP(unsigned, WS_CTL) + CW_CNT + 32, nr); if (nc) atomicAdd(WSP(unsigned, WS_CTL) + CW_CNT + 34, nc); }
                { PHASE_IDS(); (void)ws; xcd_barrier(bar, tid); }
                { PHASE_IDS(); if (bid == 0 && tid == 0) { const unsigned nr = __hip_atomic_load(WSP(unsigned, WS_CTL) + CW_CNT + 32, __ATOMIC_RELAXED, __HIP_MEMORY_SCOPE_AGENT), nc = __hip_atomic_load(WSP(unsigned, WS_CTL) + CW_CNT + 34, __ATOMIC_RELAXED, __HIP_MEMORY_SCOPE_AGENT);
                      P.out[0] = (DBG_SEL & 1) ? (float)nc * 100.f : (float)nr * 100.f; } }
                return; }
            if (DBG_STOP == 21 && g == 0 && l == 0) {
                { PHASE_IDS(); const unsigned* zw = WSP(const unsigned, WS_Z); unsigned cz = 0, cg = 0; const size_t nz = (size_t)TG * 2048 * 2 / 4;
                  for (size_t i = (size_t)bid * NT + tid; i < 2 * nz; i += (size_t)G * NT) if (zw[i] == 0x7fc07fc0u) { if (i < nz) ++cz; else ++cg; }
                  for (size_t i = (size_t)bid * NT + tid; i < (size_t)NB * SEQ * DM; i += (size_t)G * NT) P.out[i] = 0.f;
                  if (cz) atomicAdd(WSP(unsigned, WS_CTL) + CW_CNT + 32, cz); if (cg) atomicAdd(WSP(unsigned, WS_CTL) + CW_CNT + 34, cg); }
                { PHASE_IDS(); (void)ws; xcd_barrier(bar, tid); }
                { PHASE_IDS(); if (bid == 0 && tid == 0) { P.out[0] = (float)__hip_atomic_load(WSP(unsigned, WS_CTL) + CW_CNT + 32, __ATOMIC_RELAXED, __HIP_MEMORY_SCOPE_AGENT);
                      P.out[1] = 3.0f * (float)__hip_atomic_load(WSP(unsigned, WS_CTL) + CW_CNT + 34, __ATOMIC_RELAXED, __HIP_MEMORY_SCOPE_AGENT); } }
                return; }
            if (PH(3)) {
                PHASE_IDS();
                const bf16_t* MID = WSP(const bf16_t, WS_MID); unsigned char* QN = WSP(unsigned char, WS_QN); unsigned char* KVN = WSP(unsigned char, WS_KVN); bf16_t* KR = WSP(bf16_t, WS_KR);
                const bf16_t* Z = WSP(const bf16_t, WS_Z); float* STAT = WSP(float, WS_WT);
                const float* RCOS = WSP(const float, WS_ROPE); const float* RSIN = RCOS + 2048 * 32;
                const float* qn_g = P.in[I_QNORM] + l * QLORA; const float* kvn_g = P.in[I_KVNORM] + l * KVLORA;
                const f32x4 kvg = *(const f32x4*)(kvn_g + lane * 4), qg4 = *(const f32x4*)(qn_g + lane * 4); const f32x2 qg2 = *(const f32x2*)(qn_g + 256 + lane * 2);
                constexpr int NR = 4;
                u32x2 kvw[NR], qaw[NR]; unsigned qbw[NR], krw[NR]; u32x4 zw[NR]; float csw[NR], snw[NR];
#define P2A_FETCH(blk_, KV, QA, QB, KR, ZW) do { _Pragma("unroll") for (int k2 = 0; k2 < NR; ++k2) { const int r_ = (blk_) * (8 * NR) + wid * NR + k2; const bf16_t* mp_ = MID + (size_t)r_ * NMID; \
        { const int bl_ = r_ / RPB, pos_ = r_ - bl_ * RPB - CTX; const int pc_ = pos_ >= 0 ? pos_ : 0; const int i_ = 4 * (lane >> 3) + (lane & 3); csw[k2] = RCOS[pc_ * 32 + i_]; snw[k2] = RSIN[pc_ * 32 + i_]; } \
        KV[k2] = *(const u32x2*)(mp_ + lane * 4); QA[k2] = *(const u32x2*)(mp_ + 320 + lane * 4); QB[k2] = *(const unsigned*)(mp_ + 320 + 256 + lane * 2); KR[k2] = (unsigned)mp_[256 + lane]; \
        ZW[k2] = *(const u32x4*)((const unsigned char*)Z + (size_t)r_ * 2048 + 1024 + lane * 16); } } while (0)
                REPS(3) {
                for (int blk = bid; blk < TG / (8 * NR); blk += G) {
                    P2A_FETCH(blk, kvw, qaw, qbw, krw, zw);
                    asm volatile("" ::: "memory");
#pragma unroll
                for (int k2 = 0; k2 < NR; ++k2) {
                    const int r = blk * (8 * NR) + wid * NR + k2;
                    const int bl = r / RPB, rr = r - bl * RPB, pos = rr - CTX;
                    const f32x4 kv = {bf_lo(kvw[k2].x), bf_hi(kvw[k2].x), bf_lo(kvw[k2].y), bf_hi(kvw[k2].y)};
                    float s = kv[0] * kv[0] + kv[1] * kv[1] + kv[2] * kv[2] + kv[3] * kv[3]; s = wave_sum(s);
                    float rs = 1.0f / sqrtf(s * (1.0f / 256.0f) + LN_EPS);
                    { const f32x4 o = kv * rs * kvg; *(unsigned*)(KVN + (size_t)r * 256 + lane * 4) = cvt_pk4_fp8(o[0], o[1], o[2], o[3]); }
                    const f32x4 qa = {bf_lo(qaw[k2].x), bf_hi(qaw[k2].x), bf_lo(qaw[k2].y), bf_hi(qaw[k2].y)}; const f32x2 qb = {bf_lo(qbw[k2]), bf_hi(qbw[k2])};
                    s = qa[0] * qa[0] + qa[1] * qa[1] + qa[2] * qa[2] + qa[3] * qa[3] + qb[0] * qb[0] + qb[1] * qb[1]; s = wave_sum(s);
                    rs = 1.0f / sqrtf(s * (1.0f / 384.0f) + LN_EPS);
                    { const f32x4 o = qa * rs * qg4; *(unsigned*)(QN + (size_t)r * 512 + lane * 4) = cvt_pk4_fp8(o[0], o[1], o[2], o[3]);
                      const f32x2 o2 = qb * rs * qg2; *(unsigned short*)(QN + (size_t)r * 512 + 256 + lane * 2) = (unsigned short)__builtin_amdgcn_cvt_pk_fp8_f32(o2[0], o2[1], 0, false);
                      *(unsigned short*)(QN + (size_t)r * 512 + 384 + lane * 2) = (unsigned short)0; }
                    { const float v = __uint_as_float(krw[k2] << 16); const float pv = __uint_as_float((unsigned)__builtin_amdgcn_ds_swizzle((int)__float_as_uint(v), 0x101F));   float o = v;
                      if (pos >= 0) { const float cs = csw[k2], sn = snw[k2];
                          o = (lane & 4) ? (pv * sn + v * cs) : (v * cs - pv * sn); }
                      ((unsigned char*)KR)[(size_t)r * 64 + lane] = (unsigned char)__builtin_amdgcn_cvt_pk_fp8_f32(o, o, 0, false); }
                    { const u32x4 w0 = zw[k2]; float sm = 0.f, s2 = 0.f;
#define ACC2(w) { const f32x4 a = fp8x4_f32(w); sm += (a[0] + a[1]) + (a[2] + a[3]); s2 += (a[0] * a[0] + a[1] * a[1]) + (a[2] * a[2] + a[3] * a[3]); }
                      ACC2(w0.x) ACC2(w0.y) ACC2(w0.z) ACC2(w0.w)
#undef ACC2
                      sm = wave_sum(sm); s2 = wave_sum(s2); const float mean = sm * (1.0f / 1024.0f); const float var = fmaxf(s2 * (1.0f / 1024.0f) - mean * mean, 0.f);
                      if (lane == 0) { f32x2 st = {mean, 1.0f / sqrtf(var + LN_EPS)}; *(f32x2*)(STAT + 2 * (size_t)r) = st; } }
                }
                } }
#undef P2A_FETCH
            }
            { PHASE_IDS(); (void)ws; xcd_barrier(bar, tid); }
            if (PH(4)) {
                PHASE_IDS();
                const unsigned char* Z = WSP(const unsigned char, WS_Z); unsigned char* GM = WSP(unsigned char, WS_GM); const float* STAT = WSP(const float, WS_WT);
                LAS char* VN = (LAS char*)lds;
                LAS f32x4* LNL = (LAS f32x4*)(lds + 36864);
                LAS unsigned char* RAW = lds + 49152;
                LAS unsigned char* URAW = lds + 81920;
                LAS unsigned char* STS = lds + 114688;
                for (int o = tid; o < 512; o += NT) LNL[o] = *(const f32x4*)((o < 256 ? P.in[I_GMLNG] : P.in[I_GMLNB]) + l * 1024 + (o & 255) * 4);
                const float* bs = P.in[I_GMBS] + l * 8 * 128; const bf16_t* Wsl = WSP(const bf16_t, WS_WS) + (size_t)l * 8 * 128 * 128;
                const int r32 = lane & 31, hi = lane >> 5;
                const int i0 = 32 * (wid & 3), chh = wid >> 2;
                const int nun = (last ? GB * 16 : TG / 128) * 8;
#define GM_ROW0(un) ((size_t)(last ? (((un) >> 3) >> 4) * 18 + 2 + (((un) >> 3) & 15) : ((un) >> 3)) * 128)
#define GM_DMA(un, b) do { const size_t row0_ = GM_ROW0(un); const unsigned char* zr_ = Z + (row0_ + (tid >> 3)) * 2048 + ((un) & 7) * 128; \
        const unsigned char* zv_ = zr_ + 1024 + (tid & 7) * 16; const unsigned char* zu_ = zr_ + (((tid & 7) ^ ((tid >> 3) & 7)) * 16); \
        __builtin_amdgcn_global_load_lds((const unsigned*)zv_, (LAS unsigned*)(RAW + (b) * 16384 + wid * 1024), 16, 0, 0); \
        __builtin_amdgcn_global_load_lds((const unsigned*)(zv_ + (size_t)64 * 2048), (LAS unsigned*)(RAW + (b) * 16384 + 8192 + wid * 1024), 16, 0, 0); \
        __builtin_amdgcn_global_load_lds((const unsigned*)zu_, (LAS unsigned*)(URAW + (b) * 16384 + wid * 1024), 16, 0, 0); \
        __builtin_amdgcn_global_load_lds((const unsigned*)(zu_ + (size_t)64 * 2048), (LAS unsigned*)(URAW + (b) * 16384 + 8192 + wid * 1024), 16, 0, 0); \
        __builtin_amdgcn_global_load_lds((const unsigned*)(STAT + 2 * (row0_ + 2 * lane)), (LAS unsigned*)(STS + (b) * 8192 + wid * 1024), 16, 0, 0); } while (0)
#define GM_LDW(gi_) do { const bf16_t* wp = Wsl + ((size_t)(gi_) * 128 + i0 + r32) * 128 + hi * 8; \
        _Pragma("unroll") for (int t2 = 0; t2 < 2; ++t2) _Pragma("unroll") for (int ks = 0; ks < 4; ++ks) pa[t2][ks] = *reinterpret_cast<const bf16x8*>(wp + t2 * 64 + ks * 16); \
        bsi = bs[(gi_) * 128 + i0 + r32]; __builtin_amdgcn_s_waitcnt(0x0F70);   } while (0)
                REPS(4) {
                __syncthreads();
                bf16x8 pa[2][4]; float bsi; int cur_gi = bid & 7;
                GM_LDW(cur_gi);
                int un = bid, kb = 0; if (un < nun) GM_DMA(un, 0);
                for (; un < nun; un += G, kb ^= 1) {
                    const int gi = un & 7; const size_t row0 = GM_ROW0(un);
                    if (gi != cur_gi) { cur_gi = gi; GM_LDW(gi); }
                    if (un + G < nun) { GM_DMA(un + G, kb ^ 1); } else { GM_DMA(un, kb ^ 1); }
                    asm volatile("s_waitcnt vmcnt(5)" ::: "memory"); __builtin_amdgcn_s_barrier();
#pragma unroll
                    for (int i = 0; i < 4; ++i) { const int idx = tid + NT * i, j = idx >> 4, c8 = (idx & 15) * 8; const int cg4 = (gi * 128 + c8) >> 2;
                        const u32x2 w = *(const LAS u32x2*)(RAW + kb * 16384 + j * 128 + c8); const f32x2 st = *(const LAS f32x2*)(STS + kb * 8192 + wid * 1024 + j * 8);
                        const float mean = st[0], rstd = st[1];
                        const f32x4 g0 = LNL[cg4], g1 = LNL[cg4 + 1], b0 = LNL[256 + cg4], b1 = LNL[256 + cg4 + 1];
                        f32x4 v0 = fp8x4_f32(w.x), v1 = fp8x4_f32(w.y);
                        v0 = (v0 - mean) * rstd * g0 + b0; v1 = (v1 - mean) * rstd * g1 + b1;
                        u32x4 o; o.x = cvt_pk_bf16(v0[0], v0[1]); o.y = cvt_pk_bf16(v0[2], v0[3]); o.z = cvt_pk_bf16(v1[0], v1[1]); o.w = cvt_pk_bf16(v1[2], v1[3]);
                        *(LAS u32x4*)(VN + (j >> 6) * 16384 + att::v_st(j & 63, c8)) = o; }
                    asm volatile("s_waitcnt lgkmcnt(0)" ::: "memory"); __builtin_amdgcn_s_barrier();
                    f32x16 o2[2] = {};
                    const int vb = (int)(uintptr_t)VN + att::v_rd_base(lane) + chh * 1024;
#pragma unroll
                    for (int t2 = 0; t2 < 2; ++t2) { att::pv_one_t<0>(o2[0], vb + t2 * 16384, pa[t2][0], pa[t2][1], pa[t2][2], pa[t2][3]); att::pv_one_t<1>(o2[1], vb + t2 * 16384, pa[t2][0], pa[t2][1], pa[t2][2], pa[t2][3]); }
                    unsigned char* gp = GM + (row0 + i0 + r32) * 1024 + gi * 128 + chh * 64 + 4 * hi;
                    const LAS unsigned char* ul = URAW + kb * 16384 + (i0 + r32) * 128 + 4 * hi; const int usw = (i0 + r32) & 7;
#pragma unroll
                    for (int dd = 0; dd < 2; ++dd)
#pragma unroll
                        for (int q = 0; q < 4; ++q) { const int bo = chh * 64 + dd * 32 + q * 8;
                            const f32x4 u4 = fp8x4_f32(*(const LAS unsigned*)(ul + (((bo >> 4) ^ usw) << 4) + (bo & 15)));
                            *(unsigned*)(gp + dd * 32 + q * 8) = cvt_pk4_fp8(u4[0] * (o2[dd][4 * q + 0] + bsi), u4[1] * (o2[dd][4 * q + 1] + bsi), u4[2] * (o2[dd][4 * q + 2] + bsi), u4[3] * (o2[dd][4 * q + 3] + bsi)); }
                    asm volatile("s_waitcnt lgkmcnt(0)" ::: "memory"); __builtin_amdgcn_s_barrier();
                }
                asm volatile("s_waitcnt vmcnt(0)" ::: "memory"); __syncthreads(); }
#undef GM_LDW
#undef GM_DMA
#undef GM_ROW0
            }
            if (PH(5)) { PHASE_IDS();
              Gemm gm{ws + WS_QN, WSP(const bf16_t, WS_WUQ) + (size_t)l * 1536 * 256, 256}; DenseOrder S; S.init(last ? GB * 8 : NPAN, 6, G, bid, last);
              EpiQ E{WSP(bf16_t, WS_MID), WSP(const float, WS_ROPE), WSP(const float, WS_ROPE) + 2048 * 32, 1.0f / WU_SCALE};
              pg8::gemm_phase<EpiQ, DenseOrder, true>(lds, gm, S, E, tid); }
            if (PH(6)) { PHASE_IDS();
              Gemm gm{ws + WS_KVN, WSP(const bf16_t, WS_WUKV) + (size_t)l * 2048 * 128, 128}; DenseOrder S; S.init(NPAN, 8, G, G - 1 - bid);
              EpiStore E{WSP(unsigned char, WS_KV), 2048, 1.0f / WU_SCALE, WSP(unsigned char, WS_MID) + (size_t)TG * 1536};
              pg8::gemm_phase<EpiStore, DenseOrder, true>(lds, gm, S, E, tid); }
            { PHASE_IDS(); (void)ws; xcd_barrier(bar, tid); }
            DBG_DUMP(4, WS_Z, WS_KV);
            if (PH(7)) {
                PHASE_IDS();
                const unsigned char* QB = WSP(const unsigned char, WS_MID);     bf16_t* ATT = WSP(bf16_t, WS_Z + (size_t)TG * 2048);
                const int vc = (G % 8 == 0) ? (bid % 8) * (G / 8) + bid / 8 : bid;
                const int nheavy = GB * NH * 8, nlight = last ? 0 : GB * NH;
                const bool spread = G >= 64 + GB * NH; int lj = spread ? bid - 64 : vc;
                REPS(7)
                for (int it = 0; ; ++it) {
                    int u = vc + it * G;
                    if (u >= nheavy) { if (lj < 0 || lj >= nlight) break; u = nheavy + lj; lj = spread ? -1 : lj + G; }
                    int bl, h, qb, ntile;
                    if (u < nheavy) { const int bh = u >> 3; bl = bh >> 3; h = bh & 7; qb = 1 + (u & 7); ntile = RPB / 64; }
                    else { const int bh = u - nheavy; bl = bh >> 3; h = bh & 7; qb = 0; ntile = CTX / 64; }
                    const size_t rb = (size_t)bl * RPB;
                    att::attn_body(QB + (rb + qb * 256) * 1536 + h * 192, ws, (unsigned)(WS_KV + ((rb >> 6) * 8 + h) * 8192), (unsigned)(WS_MID + (size_t)TG * 1536 + rb * 1024 + h * 128), (unsigned)(WS_KR + rb * 64), (bf16_t*)((unsigned char*)ATT + (rb + qb * 256) * 1024 + h * 128), ntile, (LAS char*)lds, tid);
                }
            }
            if (PH(8)) { PHASE_IDS();
              Gemm gm{ws + WS_GM, WSP(const bf16_t, WS_WPA) + (size_t)l * 1024 * 512, 512}; DenseOrder S; S.init(last ? GB * 8 : NPAN, 4, G, bid, last);
              EpiProj<false> E{WSP(bf16_t, WS_GT + (size_t)TG * 2048), WSP(const bf16_t, WS_GT), 0, nullptr, 1.0f / WIN_SCALE};
              pg8::gemm_phase<EpiProj<false>, DenseOrder, true>(lds, gm, S, E, tid); }
            { PHASE_IDS(); (void)ws; xcd_barrier(bar, tid); }
            if (PH(9)) { PHASE_IDS();
              Gemm gm{ws + WS_Z + (size_t)TG * 2048, WSP(const bf16_t, WS_WPB) + (size_t)l * 1024 * 512, 512}; DenseOrder S; S.init(last ? GB * 8 : NPAN, 4, G, bid, last);
              EpiProj<true> E{WSP(bf16_t, WS_GT + (size_t)TG * 2048), WSP(const bf16_t, WS_GT), 1024, WSP(unsigned char, WS_GM) + (size_t)TG * 1024, 1.0f / (WIN_SCALE * ATT_SCALE)};
              pg8::gemm_phase<EpiProj<true>, DenseOrder, true>(lds, gm, S, E, tid); }
            { PHASE_IDS(); (void)ws; xcd_barrier(bar, tid); }
            DBG_DUMP(6, WS_H, WS_GT);
            if (DBG_STOP == 20 && g == 0 && l == 0) { PHASE_IDS(); const bf16_t* GTp = WSP(const bf16_t, WS_GT);
                for (size_t i = (size_t)bid * NT + tid; i < (size_t)NB * SEQ * DM; i += (size_t)G * NT) { const size_t row = i >> 10, col = i & 1023; float v = 0.f;
                    if (row < (size_t)TG) v = __uint_as_float((unsigned)GTp[row * 2048 + DBG_COL0 + col] << 16); P.out[i] = 100.f * v; }
                return; }
            if (PH(10)) { PHASE_IDS();
              Gemm gm{ws + WS_GM + (size_t)TG * 1024, WSP(const bf16_t, WS_WO) + (size_t)l * 1024 * 512, 512}; DenseOrder S; S.init(last ? GB * 8 : NPAN, 4, G, bid, last);
              EpiOut E{WSP(bf16_t, WS_LAT), P.in[I_X], P.in[I_CTX], WSP(const float, WS_MOD) + (size_t)l * 33 * 6144, g, l == 0 ? 1 : 0};
              pg8::gemm_phase<EpiOut, DenseOrder, true>(lds, gm, S, E, tid); }
            { PHASE_IDS(); (void)ws; xcd_barrier(bar, tid); }
            DBG_DUMP(8, WS_H, WS_GM);
            if (PH(11)) {
                PHASE_IDS();
                bf16_t* LAT = WSP(bf16_t, WS_LAT); bf16_t* H = WSP(bf16_t, WS_H);
                const float* mod = WSP(const float, WS_MOD) + (size_t)l * 33 * 6144;
                LAS f32x4* WR = (LAS f32x4*)lds;
                LAS int* ENT = (LAS int*)(lds + 65536);
                for (int o = tid; o < 64 * 64; o += NT) { const int ln = o & 15, q = o >> 4, e4 = q & 3, j = (q >> 2) & 3, i = q >> 4; const int k = 64 * i + 4 * ln + j;
                    WR[o] = *(const f32x4*)(P.in[I_WROUTER] + (size_t)k * 16 + 4 * e4); }
                LAS f32x4* LNL = (LAS f32x4*)(lds + 114688);
                for (int o = tid; o < 512; o += NT) LNL[o] = *(const f32x4*)((o < 256 ? P.in[I_LN1G] : P.in[I_LN1B]) + l * 1024 + (o & 255) * 4);
                __syncthreads();
                const float* brt = P.in[I_BROUTER];
                int nrows3 = 0; for (int r = bid * 8; r < TG; r += G * 8) nrows3 += (TG - r) < 8 ? (TG - r) : 8;
                REPS(11) {
                for (int it = 0; it * 32 < nrows3; ++it) {
                    int lane = tid & 63; asm volatile("" : "+v"(lane));
                    const int q = lane >> 4, l16 = lane & 15; const int lr = it * 32 + wid * 4 + q;
                    const int r = (lr >> 3) * (G * 8) + bid * 8 + (lr & 7);
                    bool ok = lr < nrows3 && r < TG;
                    if (ok && last && (r % RPB) < CTX) { ok = false; if (l16 == 0) { ENT[(2 * lr) * 4] = -1; ENT[(2 * lr + 1) * 4] = -1; } }
                    if (ok) {
                        const int mr = row_mod(r, g); const float* md = mod + (size_t)mr * 6144;
                        bf16_t* lp = LAT + (size_t)r * 1024;
                        f32x4 v[16]; float sm = 0.f;
#pragma unroll
                        for (int i = 0; i < 16; ++i) { const u32x2 w = *(const u32x2*)(lp + i * 64 + l16 * 4); v[i] = (f32x4){bf_lo(w.x), bf_hi(w.x), bf_lo(w.y), bf_hi(w.y)}; sm += (v[i][0] + v[i][1]) + (v[i][2] + v[i][3]); }
                        sm = row_sum16(sm); const float mean = sm * (1.0f / 1024.0f); float qv = 0.f;
#pragma unroll
                        for (int i = 0; i < 16; ++i) { v[i] = v[i] - mean; qv += (v[i][0] * v[i][0] + v[i][1] * v[i][1]) + (v[i][2] * v[i][2] + v[i][3] * v[i][3]); }
                        qv = row_sum16(qv); const float rstd = 1.0f / sqrtf(qv * (1.0f / 1024.0f) + LN_EPS);
                        f32x4 lg4[4] = {};
                        f32x4 pc[2], ps[2];
#pragma unroll
                        for (int i = 0; i < 2; ++i) { pc[i] = *(const f32x4*)(md + 4096 + i * 64 + l16 * 4); ps[i] = *(const f32x4*)(md + 3072 + i * 64 + l16 * 4); }
#pragma unroll
                        for (int i = 0; i < 16; ++i) { const int c = i * 64 + l16 * 4;
                            const f32x4 csc = pc[i & 1], csh = ps[i & 1];
                            if (i + 2 < 16) { pc[i & 1] = *(const f32x4*)(md + 4096 + c + 128); ps[i & 1] = *(const f32x4*)(md + 3072 + c + 128); }
                            const f32x4 o = v[i] * rstd * LNL[i * 16 + l16] + LNL[256 + i * 16 + l16];
                            const f32x4 h2 = o * (1.0f + csc) + csh;
                            *(unsigned*)((unsigned char*)H + (size_t)r * 1024 + c) = cvt_pk4_fp8(h2[0], h2[1], h2[2], h2[3]);
                            f32x4 wv[16];
#pragma unroll
                            for (int q = 0; q < 16; ++q) wv[q] = WR[(i * 16 + q) * 16 + l16];
#pragma unroll
                            for (int j = 0; j < 4; ++j)
#pragma unroll
                                for (int e4 = 0; e4 < 4; ++e4) lg4[e4] = h2[j] * wv[j * 4 + e4] + lg4[e4];
                            asm volatile("" ::: "memory"); }
                        float lgt[16];
#pragma unroll
                        for (int e = 0; e < 16; ++e) lgt[e] = lg4[e >> 2][e & 3];
                        float aff[16], sel[16];
#pragma unroll
                        for (int e = 0; e < 16; ++e) { const float t = row_sum16(lgt[e]); aff[e] = fsigmoid(t); sel[e] = aff[e] + brt[e]; }
                        int grp = 0; float best = -1e30f;
#pragma unroll
                        for (int gq = 0; gq < 4; ++gq) { float m1 = -1e30f, m2 = -1e30f;
#pragma unroll
                            for (int j = 0; j < 4; ++j) { const float x = sel[4 * gq + j]; if (x > m1) { m2 = m1; m1 = x; } else if (x > m2) m2 = x; }
                            const float sc = m1 + m2; if (sc > best) { best = sc; grp = gq; } }
                        float s4[4], a4[4];
#pragma unroll
                        for (int j = 0; j < 4; ++j) { s4[j] = grp == 0 ? sel[j] : grp == 1 ? sel[4 + j] : grp == 2 ? sel[8 + j] : sel[12 + j]; a4[j] = grp == 0 ? aff[j] : grp == 1 ? aff[4 + j] : grp == 2 ? aff[8 + j] : aff[12 + j]; }
                        int i0 = 0; float b0 = s4[0];
#pragma unroll
                        for (int j = 1; j < 4; ++j) if (s4[j] > b0) { b0 = s4[j]; i0 = j; }
                        int i1 = -1; float b1 = -1e30f;
#pragma unroll
                        for (int j = 0; j < 4; ++j) if (j != i0 && s4[j] > b1) { b1 = s4[j]; i1 = j; }
                        const float w0 = i0 == 0 ? a4[0] : i0 == 1 ? a4[1] : i0 == 2 ? a4[2] : a4[3], w1 = i1 == 0 ? a4[0] : i1 == 1 ? a4[1] : i1 == 2 ? a4[2] : a4[3];
                        const float inv = 1.0f / (w0 + w1);
                        if (l16 == 0) { const int e0 = grp * 4 + i0, e1 = grp * 4 + i1;
                            ENT[(2 * lr) * 4 + 0] = e0; ENT[(2 * lr) * 4 + 1] = 2 * r; ENT[(2 * lr + 1) * 4 + 0] = e1; ENT[(2 * lr + 1) * 4 + 1] = 2 * r + 1;
                            float* wtl = WSP(float, WS_WT) + (size_t)bid * WGSTR + 2 * lr; wtl[0] = w0 * inv; wtl[1] = w1 * inv; }
                    }
                }
                __syncthreads();
                { int nrows = 0; for (int r = bid * 8; r < TG; r += G * 8) nrows += (TG - r) < 8 ? (TG - r) : 8;
                  LAS int* WC = (LAS int*)(lds + 65536 + 32768);
                  const int ln = tid & 63; const int n = tid; const int e = n < 2 * nrows ? ENT[n * 4] : -1; int myrank = 0;
#pragma unroll
                  for (int ee = 0; ee < 16; ++ee) { const unsigned long long mask = __ballot(e == ee); if (e == ee) myrank = __popcll(mask & ((1ull << ln) - 1ull)); if (ln == 0) WC[wid * 16 + ee] = __popcll(mask); }
                  __syncthreads();
                  if (tid < 16) { int run = 0;
#pragma unroll
                      for (int w = 0; w < 8; ++w) { const int c = WC[w * 16 + tid]; WC[w * 16 + tid] = run; run += c; } WC[128 + tid] = run; }
                  __syncthreads();
                  if (e >= 0) ENT[n * 4 + 3] = WC[wid * 16 + e] + myrank;
                  if (tid < 32) __hip_atomic_store(WSP(int, WS_CTL + 32768) + bid * 32 + tid, tid < 16 ? WC[128 + tid] : 0, __ATOMIC_RELAXED, __HIP_MEMORY_SCOPE_AGENT); }
                if (DBG_REP == 11) __syncthreads(); }
            }
            { PHASE_IDS(); (void)ws; xcd_barrier(bar, tid); }
            DBG_DUMP(9, WS_H, WS_GM);
            if (PH(11)) {
                PHASE_IDS();
                LAS int* ENT = (LAS int*)(lds + 65536);
                LAS int* CL = (LAS int*)(lds + 65536 + 16384);
                const int* WGC = WSP(const int, WS_CTL + 32768);
                REPS(12) {
                if (tid < 32) CL[tid] = 0;
                __syncthreads();
                for (int o = tid; o < G * 16; o += NT) { const int b = o >> 4, e = o & 15; const int c = __hip_atomic_load(WGC + b * 32 + e, __ATOMIC_RELAXED, __HIP_MEMORY_SCOPE_AGENT);
                    if (c) { if (b < bid) __hip_atomic_fetch_add(&CL[e], c, __ATOMIC_RELAXED, __HIP_MEMORY_SCOPE_WORKGROUP); __hip_atomic_fetch_add(&CL[16 + e], c, __ATOMIC_RELAXED, __HIP_MEMORY_SCOPE_WORKGROUP); } }
                __syncthreads();
                if (tid == 0) { int a = 0, sb = 0; for (int e = 0; e < 16; ++e) { const int n = CL[16 + e]; PRE[e] = a; PRE[17 + e] = n; PRE[33 + e] = sb; a += (n + 255) >> 8; sb += n; } PRE[16] = a; }
                __syncthreads();
                int nrows = 0; for (int r = bid * 8; r < TG; r += G * 8) nrows += (TG - r) < 8 ? (TG - r) : 8;
                for (int n = tid; n < 2 * nrows; n += NT) { const int e = ENT[n * 4]; if (e >= 0) ENT[n * 4 + 3] += PRE[33 + e] + CL[e]; }
                __syncthreads();
                int* SLT = WSP(int, WS_LIST) + (size_t)bid * WGSTR;
                for (int n = tid; n < 2 * nrows; n += NT) SLT[n] = ENT[n * 4 + 3];
                const unsigned char* H = WSP(const unsigned char, WS_H); unsigned char* HS = WSP(unsigned char, WS_KV);
                for (int n0 = wid * 8; n0 < 2 * nrows; n0 += 64) {
                    u32x4 cv[8]; int csl[8];
#pragma unroll
                    for (int k = 0; k < 8; ++k) { const int n = n0 + k; const bool okc = n < 2 * nrows && ENT[(n < 2 * nrows ? n : 0) * 4] >= 0; const int nn = okc ? n : 0;
                        const int a = ENT[nn * 4 + 1]; csl[k] = okc ? ENT[nn * 4 + 3] : -1;
                        cv[k] = ((const u32x4*)(H + (size_t)((okc ? a : 0) >> 1) * 1024))[lane]; }
                    asm volatile("" ::: "memory");
#pragma unroll
                    for (int k = 0; k < 8; ++k) if (csl[k] >= 0) ((u32x4*)(HS + (size_t)csl[k] * 1024))[lane] = cv[k];
                    asm volatile("" ::: "memory"); }
                if (DBG_REP == 12 && rep_ == 0) { __syncthreads(); for (int n = tid; n < 2 * nrows; n += NT) { const int e = ENT[n * 4]; if (e >= 0) ENT[n * 4 + 3] -= PRE[33 + e] + CL[e]; } __syncthreads(); } }
            }
            { PHASE_IDS(); (void)ws; xcd_barrier(bar, tid); }
            if (DBG_STOP == 16 && g == 0 && l == 0) { PHASE_IDS(); const float* WSL = WSP(const float, WS_WT); const int* SLOT = WSP(const int, WS_LIST);
                for (size_t i = (size_t)bid * NT + tid; i < (size_t)NB * SEQ * DM; i += (size_t)G * NT) P.out[i] = i < (size_t)2 * TG ? WSL[i] : i < (size_t)4 * TG ? (float)SLOT[i - 2 * TG] * 1e-3f : 0.f;
                return; }
            if (PH(12)) { PHASE_IDS();
              Gemm gm{ws + WS_KV, WSP(const bf16_t, WS_WGU) + (size_t)l * 16 * 1024 * 512, 512}; MoeOrder S{PRE, G, bid};
              EpiGU E{WSP(bf16_t, WS_GT), PRE};
              pg8::gemm_phase<EpiGU, MoeOrder, true>(lds, gm, S, E, tid); }
            { PHASE_IDS(); (void)ws; xcd_barrier(bar, tid); }
            DBG_DUMP(10, WS_GT, WS_GM);
            if (PH(13)) { PHASE_IDS();
              Gemm gm{ws + WS_GT, WSP(const bf16_t, WS_WD) + (size_t)l * 16 * 1024 * (DE / 2), DE / 2}; MoeOrder S{PRE, G, bid};
              EpiDown E{WSP(bf16_t, WS_Z), PRE};
              pg8::gemm_phase<EpiDown, MoeOrder, true>(lds, gm, S, E, tid); }
            { PHASE_IDS(); (void)ws; xcd_barrier(bar, tid); }
            DBG_DUMP(11, WS_Z, WS_Z + (size_t)TG * 1024 * 2);
            if (PH(14)) {
                PHASE_IDS();
                bf16_t* LAT = WSP(bf16_t, WS_LAT); bf16_t* H = WSP(bf16_t, WS_H); const bf16_t* OUTB = WSP(const bf16_t, WS_Z); const int* SLT = WSP(const int, WS_LIST) + (size_t)bid * WGSTR; const float* WTL = WSP(const float, WS_WT) + (size_t)bid * WGSTR;
                const float* mod = WSP(const float, WS_MOD) + (size_t)l * 33 * 6144;
                LAS f32x4* LNL = (LAS f32x4*)lds;
                for (int o = tid; o < 512; o += NT) LNL[o] = *(const f32x4*)((o < 256 ? P.in[I_LN2G] : P.in[I_LN2B]) + l * 1024 + (o & 255) * 4);
                LAS f32x4* G2L = (LAS f32x4*)(lds + 8192);
                for (int o = tid; o < 17 * 256; o += NT) { const int mrow = o >> 8; G2L[o] = *(const f32x4*)(mod + (size_t)(mrow == 16 ? 32 : g * GB + mrow) * 6144 + 5120 + (o & 255) * 4); }
                LAS f32x4* L1L = (LAS f32x4*)(lds + 8192 + 17 * 4096);
                for (int o = tid; o < 512; o += NT) L1L[o] = *(const f32x4*)((o < 256 ? P.in[I_LN1G] : P.in[I_LN1B]) + l * 1024 + (o & 255) * 4);
                __syncthreads();
                const float* modn = WSP(const float, WS_MOD) + (size_t)((l + 1) % DEPTH) * 33 * 6144;
                int nrows = 0; for (int r = bid * 8; r < TG; r += G * 8) nrows += (TG - r) < 8 ? (TG - r) : 8;
                REPS(14) {
                bf16_t* LATO = (DBG_REP == 14 && rep_ == 0) ? WSP(bf16_t, WS_GM) : LAT;
                for (int it = 0; it * 32 < nrows; ++it) {
                    int lane = tid & 63; asm volatile("" : "+v"(lane));
                    const int q = lane >> 4, l16 = lane & 15; const int lr = it * 32 + wid * 4 + q;
                    const int r = (lr >> 3) * (G * 8) + bid * 8 + (lr & 7);
                    const int bl = r / RPB, rr = r - bl * RPB, gb = g * GB + bl; const int mr = rr < CTX ? 32 : gb;
                    const bool ok = lr < nrows && r < TG && !(l == DEPTH - 1 && rr < CTX);
                    if (ok) {
                        const float* md = mod + (size_t)mr * 6144; bf16_t* lp = LAT + (size_t)r * 1024;
                        const int s0 = SLT[2 * lr], s1 = SLT[2 * lr + 1]; const float rw0 = WTL[2 * lr] * (1.0f / OUT_SCALE), rw1 = WTL[2 * lr + 1] * (1.0f / OUT_SCALE);
                        const unsigned char* o0 = (const unsigned char*)OUTB + (size_t)s0 * 1024; const unsigned char* o1 = (const unsigned char*)OUTB + (size_t)s1 * 1024;
                        f32x4 v[16]; float sm = 0.f;
                        unsigned a8[16], b8[16]; u32x2 lw[16];
#pragma unroll
                        for (int i = 0; i < 16; ++i) { const int c = i * 64 + l16 * 4; a8[i] = *(const unsigned*)(o0 + c); b8[i] = *(const unsigned*)(o1 + c); lw[i] = *(const u32x2*)(lp + c); }
                        asm volatile("" ::: "memory");
                        const int g2o = (rr < CTX ? 16 : bl) * 256 + l16;
                        float sa = 0.f;
#pragma unroll
                        for (int i = 0; i < 16; ++i) { v[i] = (f32x4){bf_lo(lw[i].x), bf_hi(lw[i].x), bf_lo(lw[i].y), bf_hi(lw[i].y)}; sa += (v[i][0] + v[i][1]) + (v[i][2] + v[i][3]); }
                        sa = row_sum16(sa); const float mean1 = sa * (1.0f / 1024.0f); float q1 = 0.f;
#pragma unroll
                        for (int i = 0; i < 16; ++i) { v[i] = v[i] - mean1; q1 += (v[i][0] * v[i][0] + v[i][1] * v[i][1]) + (v[i][2] * v[i][2] + v[i][3] * v[i][3]); }
                        q1 = row_sum16(q1); const float rstd1 = 1.0f / sqrtf(q1 * (1.0f / 1024.0f) + LN_EPS);
#pragma unroll
                        for (int i = 0; i < 16; ++i) { const f32x4 a = fp8x4_f32(a8[i]), b = fp8x4_f32(b8[i]);
                            const f32x4 f = rw0 * a + rw1 * b;
                            const f32x4 lv = v[i] * rstd1 * L1L[i * 16 + l16] + L1L[256 + i * 16 + l16];
                            v[i] = ALPHA * lv + (DBG_NOMOE ? 0.f : 1.f) * G2L[g2o + i * 16] * f; sm += (v[i][0] + v[i][1]) + (v[i][2] + v[i][3]); }
                        sm = row_sum16(sm); const float mean = sm * (1.0f / 1024.0f); float qv = 0.f;
#pragma unroll
                        for (int i = 0; i < 16; ++i) { v[i] = v[i] - mean; qv += (v[i][0] * v[i][0] + v[i][1] * v[i][1]) + (v[i][2] * v[i][2] + v[i][3] * v[i][3]); }
                        qv = row_sum16(qv); const float rstd = 1.0f / sqrtf(qv * (1.0f / 1024.0f) + LN_EPS);
                        if (l == DEPTH - 1) {
#pragma unroll
                            for (int i = 0; i < 16; ++i) { const int c = i * 64 + l16 * 4;
                                const f32x4 o = v[i] * rstd * LNL[i * 16 + l16] + LNL[256 + i * 16 + l16];
                                *(f32x4*)(P.out + ((size_t)gb * SEQ + (rr - CTX)) * 1024 + c) = o; }
                        } else {
                            const float* mn = modn + (size_t)mr * 6144 + l16 * 4; f32x4 pc[2], ps[2];
#pragma unroll
                            for (int i = 0; i < 2; ++i) { ps[i] = *(const f32x4*)(mn + i * 64); pc[i] = *(const f32x4*)(mn + 1024 + i * 64); }
#pragma unroll
                            for (int i = 0; i < 16; ++i) { const int c = i * 64 + l16 * 4;
                                const f32x4 o = v[i] * rstd * LNL[i * 16 + l16] + LNL[256 + i * 16 + l16];
                                { u32x2 wl; wl.x = cvt_pk_bf16(o[0], o[1]); wl.y = cvt_pk_bf16(o[2], o[3]); *(u32x2*)(LATO + (size_t)r * 1024 + c) = wl; }
                                const f32x4 mdn_sh = ps[i & 1], mdn_sc = pc[i & 1];
                                if (i + 2 < 16) { ps[i & 1] = *(const f32x4*)(mn + (i + 2) * 64); pc[i & 1] = *(const f32x4*)(mn + 1024 + (i + 2) * 64); }
                                const f32x4 h = o * (1.0f + mdn_sc) + mdn_sh; *(unsigned*)((unsigned char*)H + (size_t)r * 1024 + c) = cvt_pk4_fp8(h[0], h[1], h[2], h[3]);
                                asm volatile("" ::: "memory"); }
                        }
                    }
                }
                }
            }
            { PHASE_IDS(); (void)ws; xcd_barrier(bar, tid); }
        }
    }
    { PHASE_IDS(); if (bid == 0 && tid == 0 && xb_ld(WSP(unsigned, WS_CTL) + CW_BAR + XB_TMO) != 0u) P.out[0] = __builtin_nanf(""); }
#undef PHASE_IDS
#undef WSP
}

constexpr int LDS_BYTES = 131072 + 1024;
extern "C" void kernel_launch(void* const* d_in, const int* in_sizes, int n_in, void* d_out, int out_size, void* d_ws, size_t ws_size, hipStream_t stream) {
    static int grid = 0;
    if (grid == 0) {
        if (n_in != 28 || out_size != NB * SEQ * DM || ws_size < WS_END) { fprintf(stderr, "kernel_launch: unexpected problem (n_in %d, out %d, ws %zu < %zu)\n", n_in, out_size, ws_size, (size_t)WS_END); grid = -1; return; }
        int dev = 0, cus = 0;
        if (hipGetDevice(&dev) != hipSuccess || hipDeviceGetAttribute(&cus, hipDeviceAttributeMultiprocessorCount, dev) != hipSuccess) { grid = -1; return; }
        if (hipFuncSetAttribute((const void*)mk_fwd, hipFuncAttributeMaxDynamicSharedMemorySize, LDS_BYTES) != hipSuccess) { fprintf(stderr, "kernel_launch: hipFuncSetAttribute failed\n"); grid = -1; return; }
        int per_cu = 0;
        if (hipOccupancyMaxActiveBlocksPerMultiprocessor(&per_cu, (const void*)mk_fwd, NT, LDS_BYTES) != hipSuccess || per_cu < 1) fprintf(stderr, "kernel_launch: occupancy query says %d\n", per_cu);
        (void)hipGetLastError();
        grid = cus;
    }
    if (grid < 0) return;
    if (hipMemsetAsync((char*)d_ws + WS_CTL, 0, CTL_BYTES, stream) != hipSuccess) return;
    Params p{};
    for (int i = 0; i < 28; ++i) p.in[i] = (const float*)d_in[i];
    p.out = (float*)d_out; p.ws = (unsigned char*)d_ws;
    hipLaunchKernelGGL(mk_fwd, dim3(grid), dim3(NT), LDS_BYTES, stream, p);
}
```
